# Optimizing an MI355X kernel written in HIP

```python
import jax, jax.numpy as jnp
from jax import lax
import numpy as np

D_MODEL = 1024
BATCH = 4
SEQ = 4096
DEPTH = 2
DEC_BATCH = 8
DEC_SEQ = 16
PAST_LEN = 2048

CHUNK = 64
N_A = DEPTH // 2
MIX_W = D_MODEL // 2
POOL_WINDOWS = (2, 4, 8, 16)
POOL_GROUP = MIX_W // len(POOL_WINDOWS)
POOL_BUF = max(POOL_WINDOWS) - 1
FOX_HEADS = 8
FOX_HD = MIX_W // FOX_HEADS
MEM_HEADS = 4
MEM_W = D_MODEL - MIX_W
MEM_HD = MEM_W // MEM_HEADS
N_MEM = 256
D_FF = 4 * D_MODEL
Q_BLOCK = 128
EPS = 1e-6
FORGET_BIAS = 3.0

kernel_name = "yoco_pool_fox_mem_streaming_step"


def rmsnorm(x, g):
    xf = x.astype(jnp.float32)
    y = xf * lax.rsqrt(jnp.mean(xf * xf, axis=-1, keepdims=True) + EPS) * g.astype(jnp.float32)
    return y.astype(x.dtype)


def pool_mixer(u, u_prev, w_pool, scale):
    B, T, _ = u.shape
    P = u_prev.shape[1]
    ext = jnp.concatenate([u_prev.astype(u.dtype), u], axis=1)
    cs = jnp.cumsum(ext.astype(jnp.float32), axis=1)
    cs = jnp.concatenate([jnp.zeros((B, 1, MIX_W), jnp.float32), cs], axis=1)
    hi = np.arange(P, P + T) + 1
    outs = []
    for g, w in enumerate(POOL_WINDOWS):
        lo = np.maximum(hi - w, 0)
        cnt = jnp.asarray((hi - lo).astype(np.float32))[None, :, None]
        csg = cs[..., g * POOL_GROUP:(g + 1) * POOL_GROUP]
        mean = (csg[:, hi] - csg[:, lo]) / cnt
        outs.append(mean - u[..., g * POOL_GROUP:(g + 1) * POOL_GROUP].astype(jnp.float32))
    pooled = jnp.stack(outs, axis=2).astype(u.dtype)
    y = jnp.einsum('btgc,gcd->btgd', pooled, w_pool).reshape(B, T, MIX_W) * scale
    return y, ext[:, -POOL_BUF:]


def shared_kvf(x, g_kv, w_kvf, b_f):
    B, T, _ = x.shape
    kvf = rmsnorm(x, g_kv) @ w_kvf
    k = kvf[..., :MIX_W].reshape(B, T, FOX_HEADS, FOX_HD)
    v = kvf[..., MIX_W:2 * MIX_W].reshape(B, T, FOX_HEADS, FOX_HD)
    logf = jax.nn.log_sigmoid(kvf[..., 2 * MIX_W:].astype(jnp.float32) + b_f.astype(jnp.float32))
    return k, v, logf


def fox_attention(q, k_all, v_all, logf_all, P):
    B, T = q.shape[:2]
    L = k_all.shape[1]
    C = jnp.cumsum(logf_all.astype(jnp.float32), axis=1)
    ck = jnp.transpose(C, (0, 2, 1))[:, :, None, :]
    cq = C[:, P:]
    kpos = jnp.arange(L)
    qpos = P + jnp.arange(T)
    scale = FOX_HD ** -0.5

    def block(args):
        qb, cqb, qpb = args
        s = jnp.einsum('bqhd,bkhd->bhqk', qb, k_all, preferred_element_type=jnp.float32) * scale
        s = s + jnp.transpose(cqb, (0, 2, 1))[..., None] - ck
        s = jnp.where(kpos[None, None, None, :] <= qpb[None, None, :, None], s, -jnp.inf)
        p = jax.nn.softmax(s, axis=-1).astype(v_all.dtype)
        return jnp.einsum('bhqk,bkhd->bqhd', p, v_all)

    if T % Q_BLOCK == 0:
        nb = T // Q_BLOCK
        qb = q.reshape(B, nb, Q_BLOCK, FOX_HEADS, FOX_HD).transpose(1, 0, 2, 3, 4)
        cqb = cq.reshape(B, nb, Q_BLOCK, FOX_HEADS).transpose(1, 0, 2, 3)
        qpb = qpos.reshape(nb, Q_BLOCK)
        out = lax.map(block, (qb, cqb, qpb))
        out = out.transpose(1, 0, 2, 3, 4)
    else:
        out = block((q, cq, qpos))
    return out.reshape(B, T, MIX_W)


def mem_project(mem, g_mem_l, w_mem_kv_l):
    B, N, _ = mem.shape
    kv = rmsnorm(mem, g_mem_l) @ w_mem_kv_l
    mk = kv[..., :MEM_W].reshape(B, N, MEM_HEADS, MEM_HD)
    mv = kv[..., MEM_W:].reshape(B, N, MEM_HEADS, MEM_HD)
    return mk, mv


def mem_attention(q, mk, mv):
    B, T, _ = q.shape
    qh = q.reshape(B, T, MEM_HEADS, MEM_HD)
    s = jnp.einsum('bqhd,bkhd->bhqk', qh, mk, preferred_element_type=jnp.float32) * (MEM_HD ** -0.5)
    p = jax.nn.softmax(s, axis=-1).astype(mv.dtype)
    return jnp.einsum('bhqk,bkhd->bqhd', p, mv).reshape(B, T, MEM_W)


def squared_relu_mlp(x, g_pre, g_post, w_up, w_down):
    a = jnp.square(jax.nn.relu(rmsnorm(x, g_pre) @ w_up))
    return rmsnorm(a @ w_down, g_post)


def run_trunk(x, pool_prev, k_prev, v_prev, logf_prev, mem_k, mem_v,
              g_mix_pre, g_mix_post, g_mlp_pre, g_mlp_post, w_in, w_out, w_pool, pool_scale,
              g_kv, w_kvf, b_f, w_up, w_down):
    P_kv = k_prev.shape[1]
    pool_states = []
    k_new = v_new = logf_new = None
    k_all = v_all = logf_all = None
    for l in range(DEPTH):
        h = rmsnorm(x, g_mix_pre[l])
        proj = h @ w_in[l]
        mix_in, mem_q = proj[..., :MIX_W], proj[..., MIX_W:]
        if l < N_A:
            mix_out, st = pool_mixer(mix_in, pool_prev[l], w_pool[l], pool_scale[l])
            pool_states.append(st)
        else:
            if k_new is None:
                k_new, v_new, logf_new = shared_kvf(x, g_kv, w_kvf, b_f)
                k_all = jnp.concatenate([k_prev.astype(k_new.dtype), k_new], axis=1)
                v_all = jnp.concatenate([v_prev.astype(v_new.dtype), v_new], axis=1)
                logf_all = jnp.concatenate([logf_prev.astype(jnp.float32), logf_new], axis=1)
            B, T, _ = mix_in.shape
            q = mix_in.reshape(B, T, FOX_HEADS, FOX_HD)
            mix_out = fox_attention(q, k_all, v_all, logf_all, P_kv)
        mem_out = mem_attention(mem_q, mem_k[l], mem_v[l])
        x = x + rmsnorm(jnp.concatenate([mix_out.astype(x.dtype), mem_out.astype(x.dtype)], axis=-1) @ w_out[l],
                        g_mix_post[l])
        x = x + squared_relu_mlp(x, g_mlp_pre[l], g_mlp_post[l], w_up[l], w_down[l])
    return x, jnp.stack(pool_states, axis=0), k_new, v_new, logf_new


def setup_inputs(seed: int = 0) -> dict:
    key = jax.random.key(seed)
    ks = jax.random.split(key, 32)

    def nrm(k, shape, scale=1.0):
        return jax.random.normal(k, shape, jnp.float32) * scale

    def gain(k, shape):
        return 1.0 + 0.05 * jax.random.normal(k, shape, jnp.float32)

    w_kvf = jnp.concatenate([nrm(ks[20], (D_MODEL, 2 * MIX_W), D_MODEL ** -0.5),
                             nrm(ks[21], (D_MODEL, FOX_HEADS), 0.5 * D_MODEL ** -0.5)], axis=1)
    return {
        "x_prompt": nrm(ks[0], (BATCH, SEQ, D_MODEL)),
        "x_sample": nrm(ks[1], (DEC_BATCH, DEC_SEQ, D_MODEL)),
        "cache_pool": nrm(ks[2], (N_A, DEC_BATCH, POOL_BUF, MIX_W)),
        "cache_k": nrm(ks[3], (DEC_BATCH, PAST_LEN, FOX_HEADS, FOX_HD)),
        "cache_v": nrm(ks[4], (DEC_BATCH, PAST_LEN, FOX_HEADS, FOX_HD)),
        "cache_logf": jax.nn.log_sigmoid(FORGET_BIAS + nrm(ks[5], (DEC_BATCH, PAST_LEN, FOX_HEADS), 0.5)),
        "cache_mem_k": nrm(ks[6], (DEPTH, DEC_BATCH, N_MEM, MEM_HEADS, MEM_HD)),
        "cache_mem_v": nrm(ks[7], (DEPTH, DEC_BATCH, N_MEM, MEM_HEADS, MEM_HD)),
        "mem_prompt": nrm(ks[8], (BATCH, N_MEM, D_MODEL)),
        "g_mix_pre": gain(ks[9], (DEPTH, D_MODEL)),
        "g_mix_post": gain(ks[10], (DEPTH, D_MODEL)),
        "g_mlp_pre": gain(ks[11], (DEPTH, D_MODEL)),
        "g_mlp_post": gain(ks[12], (DEPTH, D_MODEL)),
        "w_in": nrm(ks[13], (DEPTH, D_MODEL, MIX_W + MEM_W), D_MODEL ** -0.5),
        "w_out": nrm(ks[14], (DEPTH, MIX_W + MEM_W, D_MODEL), (MIX_W + MEM_W) ** -0.5),
        "w_pool": nrm(ks[15], (N_A, len(POOL_WINDOWS), POOL_GROUP, POOL_GROUP), POOL_GROUP ** -0.5),
        "pool_scale": 1.0 + 0.1 * nrm(ks[16], (N_A, MIX_W)),
        "g_kv": gain(ks[17], (D_MODEL,)),
        "w_kvf": w_kvf,
        "b_f": FORGET_BIAS + 0.5 * nrm(ks[18], (FOX_HEADS,)),
        "g_mem": gain(ks[19], (DEPTH, D_MODEL)),
        "w_mem_kv": nrm(ks[22], (DEPTH, D_MODEL, 2 * MEM_W), D_MODEL ** -0.5),
        "w_up": nrm(ks[23], (DEPTH, D_MODEL, D_FF), D_MODEL ** -0.5),
        "w_down": nrm(ks[24], (DEPTH, D_FF, D_MODEL), D_FF ** -0.5),
    }


def reference(x_prompt, x_sample, cache_pool, cache_k, cache_v, cache_logf, cache_mem_k, cache_mem_v,
              mem_prompt, g_mix_pre, g_mix_post, g_mlp_pre, g_mlp_post, w_in, w_out, w_pool, pool_scale,
              g_kv, w_kvf, b_f, g_mem, w_mem_kv, w_up, w_down):
    mks, mvs = [], []
    for l in range(DEPTH):
        mk, mv = mem_project(mem_prompt, g_mem[l], w_mem_kv[l])
        mks.append(mk)
        mvs.append(mv)
    mem_k_prompt = jnp.stack(mks, axis=0)
    mem_v_prompt = jnp.stack(mvs, axis=0)

    B = x_prompt.shape[0]
    dt = x_prompt.dtype
    no_pool = jnp.zeros((N_A, B, 0, MIX_W), dt)
    no_k = jnp.zeros((B, 0, FOX_HEADS, FOX_HD), dt)
    no_logf = jnp.zeros((B, 0, FOX_HEADS), jnp.float32)

    y_prompt, pool_state_prompt, k_prompt, v_prompt, logf_prompt = run_trunk(
        x_prompt, no_pool, no_k, no_k, no_logf, mem_k_prompt, mem_v_prompt,
        g_mix_pre, g_mix_post, g_mlp_pre, g_mlp_post, w_in, w_out, w_pool, pool_scale,
        g_kv, w_kvf, b_f, w_up, w_down)

    y_sample, pool_state_sample, k_sample, v_sample, logf_sample = run_trunk(
        x_sample, cache_pool, cache_k, cache_v, cache_logf, cache_mem_k, cache_mem_v,
        g_mix_pre, g_mix_post, g_mlp_pre, g_mlp_post, w_in, w_out, w_pool, pool_scale,
        g_kv, w_kvf, b_f, w_up, w_down)

    return (y_prompt, y_sample, pool_state_prompt, pool_state_sample,
            k_prompt, v_prompt, logf_prompt, k_sample, v_sample, logf_sample,
            mem_k_prompt, mem_v_prompt)
```

```cpp
#include <hip/hip_runtime.h>
#include <hip/hip_cooperative_groups.h>
#include <cstdio>
#include <cstdint>
namespace cg = cooperative_groups;

#define TIDX_LDS_OFF 146944
extern __shared__ __attribute__((aligned(16))) unsigned char lds_raw_[];
__device__ __forceinline__ int tidx() {
    const unsigned key = (unsigned)__builtin_amdgcn_s_getreg((5 << 11) | 4) & 63u;
    const int wv = __builtin_amdgcn_readfirstlane(((volatile const int*)(lds_raw_ + TIDX_LDS_OFF))[key]);
    return wv * 64 + (int)__builtin_amdgcn_mbcnt_hi(~0u, __builtin_amdgcn_mbcnt_lo(~0u, 0u));
}
namespace pg8 {
#define PG8_LAS __attribute__((address_space(3)))
typedef unsigned short bf16_t;
typedef short bf16x8 __attribute__((ext_vector_type(8)));
typedef float f32x4 __attribute__((ext_vector_type(4)));
typedef unsigned u32x4 __attribute__((ext_vector_type(4)));
constexpr int BM = 256, BK = 64, HALF = 128, HTB = HALF * BK * 2  , STAGE_BYTES = 8 * HTB, NXCD = 8, WGM = 8;

__host__ __device__ __forceinline__ int lds_byte(int r, int c) { const int st = (r >> 4) * 2 + (c >> 5), rr = r & 15, cc = c & 31, ob = rr * 64 + cc * 2; return st * 1024 + (ob ^ (((ob >> 9) & 1) << 5)); }
__host__ __device__ __forceinline__ void stage_rc(int b, int& R, int& C) { const int st = b / 1024, sb = b % 1024, swz = sb ^ (((sb >> 9) & 1) << 5); R = (st >> 1) * 16 + swz / 64; C = (st & 1) * 32 + (swz % 64) / 2; }
__host__ __device__ __forceinline__ int perm32(int rho) { const int n = rho >> 4, i = rho & 15; return 8 * (i >> 2) + 4 * n + (i & 3); }

struct Unit { int pm, pn; };
struct Gemm { const bf16_t* A; const bf16_t* Bt; int M, N, K; };

struct StaticOrder {
    int nM, nN, nwg, G, c;
    __host__ __device__ void init(int M, int N, int G_, int c_) { nM = M / BM; nN = N / BM; nwg = nM * nN; G = G_; c = c_; }
    __host__ __device__ bool next(int i, Unit& u) const {
        const long L = (long)i * G + c; if (L >= nwg) return false;
        int wgid = (int)L; { const int q = nwg / NXCD, r = nwg % NXCD, xcd = wgid % NXCD, off = wgid / NXCD; wgid = (xcd < r ? xcd * (q + 1) : r * (q + 1) + (xcd - r) * q) + off; }
        const int nig = WGM * nN, gid = wgid / nig, fm = gid * WGM, gsz = (nM - fm) < WGM ? (nM - fm) : WGM;
        u.pm = fm + ((wgid % nig) % gsz); u.pn = (wgid % nig) / gsz; return true;
    }
    __device__ __forceinline__ void a_ready(const Unit&) const {}
    __device__ __forceinline__ void done(const Unit&) const {}
};


typedef float f32x2_t __attribute__((ext_vector_type(2))); typedef __bf16 bf16x2_t __attribute__((ext_vector_type(2)));
typedef unsigned u32x2 __attribute__((ext_vector_type(2)));
__device__ __forceinline__ unsigned cvt_pk_bf16(float lo, float hi) { unsigned r; asm volatile("v_cvt_pk_bf16_f32 %0, %1, %2" : "=v"(r) : "v"(lo), "v"(hi)); return r; }
__device__ __forceinline__ unsigned pk2(float lo, float hi) { f32x2_t v = {lo, hi}; bf16x2_t b = __builtin_convertvector(v, bf16x2_t); return __builtin_bit_cast(unsigned, b); }

struct EpiProj {
    static constexpr bool PERM = true, AFTER_DRAIN = false;
    bf16_t* MI; bf16_t* MQ; bf16_t* KB; bf16_t* VB; float* kout; float* vout; float smi, smq; const PG8_LAS float* rs;
    __device__ __forceinline__ void operator()(const f32x4 (&acc)[2][2][4][2], const Unit& u, int wr, int wc, int fr, int fq) const {
        const int row0 = u.pm * BM + wr * 64 + fr; const int sec = u.pn >> 1; const int colt = (u.pn & 1) * 256 + wc * 32 + 8 * fq;
        bf16_t* bdst = sec == 0 ? MI : sec == 1 ? MQ : sec == 2 ? KB : VB; float* fdst = sec == 2 ? kout : sec == 3 ? vout : nullptr; const float sc = sec == 0 ? smi : sec == 1 ? smq : 1.f;
#pragma unroll
        for (int ai = 0; ai < 2; ++ai)
#pragma unroll
            for (int m = 0; m < 4; ++m) { const size_t ro = (size_t)(row0 + ai * HALF + m * 16) * 512 + colt; const float scr = rs ? sc * rs[ai * HALF + wr * 64 + m * 16 + fr] : sc;
#pragma unroll
                for (int bj = 0; bj < 2; ++bj) { const f32x4 v0 = acc[ai][bj][m][0] * scr, v1 = acc[ai][bj][m][1] * scr;
                    u32x4 w; w.x = cvt_pk_bf16(v0[0], v0[1]); w.y = cvt_pk_bf16(v0[2], v0[3]); w.z = cvt_pk_bf16(v1[0], v1[1]); w.w = cvt_pk_bf16(v1[2], v1[3]);
                    *(u32x4*)(bdst + ro + bj * HALF) = w;
                    if (fdst) { __builtin_nontemporal_store(v0, (f32x4*)(fdst + ro + bj * HALF)); __builtin_nontemporal_store(v1, (f32x4*)(fdst + ro + bj * HALF + 4)); } } }
    }
};
struct EpiUp {
    static constexpr bool PERM = true, AFTER_DRAIN = false;
    bf16_t* O; int ldc; const PG8_LAS float* rs;
    __device__ __forceinline__ void operator()(const f32x4 (&acc)[2][2][4][2], const Unit& u, int wr, int wc, int fr, int fq) const {
        const int row0 = u.pm * BM + wr * 64 + fr; const int col0 = u.pn * BM + wc * 32 + 8 * fq;
#pragma unroll
        for (int ai = 0; ai < 2; ++ai)
#pragma unroll
            for (int m = 0; m < 4; ++m) { bf16_t* rowp = O + (size_t)(row0 + ai * HALF + m * 16) * ldc + col0; const float rr = rs[ai * HALF + wr * 64 + m * 16 + fr];
#pragma unroll
                for (int bj = 0; bj < 2; ++bj) { f32x4 v0 = acc[ai][bj][m][0], v1 = acc[ai][bj][m][1];
#pragma unroll
                    for (int i = 0; i < 4; ++i) { const float a = (v0[i] > 0.f ? v0[i] : 0.f) * rr, b = (v1[i] > 0.f ? v1[i] : 0.f) * rr; v0[i] = a * a; v1[i] = b * b; }
                    u32x4 w; w.x = cvt_pk_bf16(v0[0], v0[1]); w.y = cvt_pk_bf16(v0[2], v0[3]); w.z = cvt_pk_bf16(v1[0], v1[1]); w.w = cvt_pk_bf16(v1[2], v1[3]);
                    __builtin_nontemporal_store(w, (u32x4*)(rowp + bj * HALF)); } }
    }
};
template <bool BASE_F32, bool FINAL>
struct EpiNorm {
    static constexpr bool PERM = true, AFTER_DRAIN = true;
    const void* base; float* out; bf16_t* xb; float* ssq; const float* gain; float* slots1; unsigned* cnt1;
    __device__ __forceinline__ void stats(const f32x4 (&v)[2][2][4][2], const Unit& u, int wr, int wc, int fr, int fq, PG8_LAS unsigned char* lds, int wid, int lane, float* slots, unsigned* cnt) const {
        PG8_LAS float* P = (PG8_LAS float*)lds;
        PG8_LAS float* S = (PG8_LAS float*)(lds + 4096);
#pragma unroll
        for (int ai = 0; ai < 2; ++ai)
#pragma unroll
            for (int m = 0; m < 4; ++m) {
                float s = 0.f;
#pragma unroll
                for (int bj = 0; bj < 2; ++bj)
#pragma unroll
                    for (int n = 0; n < 2; ++n) { const f32x4 x = v[ai][bj][m][n]; s += (x[0] * x[0] + x[1] * x[1]) + (x[2] * x[2] + x[3] * x[3]); }
                s += __shfl_xor(s, 16); s += __shfl_xor(s, 32);
                if (fq == 0) P[(ai * HALF + wr * 64 + m * 16 + fr) * 4 + wc] = s;
            }
        asm volatile("s_waitcnt lgkmcnt(0)" ::: "memory"); __builtin_amdgcn_s_barrier(); asm volatile("" ::: "memory");
        const int row = wid * 32 + (lane & 31);
        if (lane < 32) {
            const float s = (P[row * 4 + 0] + P[row * 4 + 1]) + (P[row * 4 + 2] + P[row * 4 + 3]);
            __hip_atomic_store(slots + ((size_t)(u.pm * BM + row) * 4 + u.pn), s, __ATOMIC_RELAXED, __HIP_MEMORY_SCOPE_AGENT);
        }
        asm volatile("s_waitcnt vmcnt(0)" ::: "memory");
        if (lane == 0) __hip_atomic_fetch_add(cnt + 64 * u.pm, 1u, __ATOMIC_RELAXED, __HIP_MEMORY_SCOPE_AGENT);
        if (wid == 0) {
            unsigned spins = 0;
            for (;;) {
                if ((unsigned)__builtin_amdgcn_readfirstlane(__hip_atomic_load(cnt + 64 * u.pm, __ATOMIC_RELAXED, __HIP_MEMORY_SCOPE_AGENT)) >= 32u) break;
                if (++spins > (1u << 22)) break;
                __builtin_amdgcn_s_sleep(2);
            }
            __builtin_amdgcn_fence(__ATOMIC_ACQUIRE, "agent");
        }
        asm volatile("s_waitcnt vmcnt(0) lgkmcnt(0)" ::: "memory"); __builtin_amdgcn_s_barrier(); asm volatile("" ::: "memory");
        if (lane < 32) {
            const float* sl = slots + (size_t)(u.pm * BM + row) * 4; float t = 0.f;
#pragma unroll
            for (int q = 0; q < 4; ++q) t += __hip_atomic_load(sl + q, __ATOMIC_RELAXED, __HIP_MEMORY_SCOPE_AGENT);
            S[row] = 1.0f / sqrtf(t * (1.0f / 1024.0f) + 1e-6f);
        }
        asm volatile("s_waitcnt vmcnt(0) lgkmcnt(0)" ::: "memory"); __builtin_amdgcn_s_barrier(); asm volatile("" ::: "memory");
    }
    __device__ __forceinline__ void fused(f32x4 (&acc)[2][2][4][2], const Unit& u, int wr, int wc, int fr, int fq, PG8_LAS unsigned char* lds, int wid, int lane) const {
        const PG8_LAS float* S = (const PG8_LAS float*)(lds + 4096);
        const int col0 = u.pn * BM + wc * 32 + 8 * fq;
        stats(acc, u, wr, wc, fr, fq, lds, wid, lane, slots1, cnt1);
        f32x4 gv[2][2];
#pragma unroll
        for (int bj = 0; bj < 2; ++bj)
#pragma unroll
            for (int n = 0; n < 2; ++n) gv[bj][n] = *(const f32x4*)(gain + col0 + bj * HALF + n * 4);
#pragma unroll
        for (int ai = 0; ai < 2; ++ai)
#pragma unroll
            for (int m = 0; m < 4; ++m) { const int r = ai * HALF + wr * 64 + m * 16 + fr; const float rs = S[r]; const size_t off = (size_t)(u.pm * BM + r) * 1024 + col0;
                float sq = 0.f;
#pragma unroll
                for (int bj = 0; bj < 2; ++bj) { f32x4 b0, b1;
                    if (BASE_F32) { b0 = __builtin_nontemporal_load((const f32x4*)((const float*)base + off + bj * HALF)); b1 = __builtin_nontemporal_load((const f32x4*)((const float*)base + off + bj * HALF + 4)); }
                    else { const u32x4 bw = __builtin_nontemporal_load((const u32x4*)((const bf16_t*)base + off + bj * HALF));
                        b0 = (f32x4){__uint_as_float(bw.x << 16), __uint_as_float(bw.x & 0xffff0000u), __uint_as_float(bw.y << 16), __uint_as_float(bw.y & 0xffff0000u)};
                        b1 = (f32x4){__uint_as_float(bw.z << 16), __uint_as_float(bw.z & 0xffff0000u), __uint_as_float(bw.w << 16), __uint_as_float(bw.w & 0xffff0000u)}; }
                    const f32x4 x0 = b0 + acc[ai][bj][m][0] * gv[bj][0] * rs, x1 = b1 + acc[ai][bj][m][1] * gv[bj][1] * rs;
                    if (FINAL) { __builtin_nontemporal_store(x0, (f32x4*)(out + off + bj * HALF)); __builtin_nontemporal_store(x1, (f32x4*)(out + off + bj * HALF + 4)); }
                    else { sq += ((x0[0] * x0[0] + x0[1] * x0[1]) + (x0[2] * x0[2] + x0[3] * x0[3])) + ((x1[0] * x1[0] + x1[1] * x1[1]) + (x1[2] * x1[2] + x1[3] * x1[3]));
                        u32x4 w; w.x = cvt_pk_bf16(x0[0], x0[1]); w.y = cvt_pk_bf16(x0[2], x0[3]); w.z = cvt_pk_bf16(x1[0], x1[1]); w.w = cvt_pk_bf16(x1[2], x1[3]); *(u32x4*)(xb + off + bj * HALF) = w; } }
                if (!FINAL) { sq += __shfl_xor(sq, 16); sq += __shfl_xor(sq, 32); if (fq == 0) ssq[(size_t)(u.pm * BM + r) * 16 + u.pn * 4 + wc] = sq; }
                if (m & 1) asm volatile("" ::: "memory"); }
    }
};

template <class Epi, class Sched, bool ALIGN_EPI = false, bool SP2 = false>
__device__ __forceinline__ void gemm_phase(PG8_LAS unsigned char* lds, const Gemm g, const Sched& S, const Epi& E) {
    const int tid = tidx(), wid = __builtin_amdgcn_readfirstlane(tid >> 6), lane = tid & 63, wr = wid >> 2, wc = wid & 3, fr = lane & 15, fq = lane >> 4;
    const int K = g.K, nt = K / BK;
    unsigned voffA[2], voffB[2];
#pragma unroll
    for (int i = 0; i < 2; ++i) { int R, C; stage_rc(tid * 16 + i * 8192, R, C); const int Rb = Epi::PERM ? ((R & ~31) + perm32(R & 31)) : R;
        voffA[i] = (unsigned)(R * K + C) * 2u; voffB[i] = (unsigned)(Rb * K + C) * 2u; }
    const size_t kstep = (size_t)(BK * 2);
    const size_t hstep = (size_t)HALF * K * 2;
    const size_t tstep = 2 * hstep;
    const unsigned ldsw = (unsigned)wid * 1024u;
    const int aoff = lds_byte(wr * 64 + fr, fq * 8), boff = lds_byte(wc * 32 + fr, fq * 8);
#define PG8_SA(b, h) (((b) * 2 + (h)) * HTB)
#define PG8_SB(b, h) ((4 + (b) * 2 + (h)) * HTB)
#define PG8_STAGE(bufoff, gbase, voff) do { _Pragma("unroll") for (int _i = 0; _i < 2; ++_i) \
        __builtin_amdgcn_global_load_lds((const unsigned*)((const char*)(gbase) + (voff)[_i]), (PG8_LAS unsigned*)(lds + (bufoff) + ldsw + _i * 8192), 16, 0, 0); } while (0)
#define PG8_LDA(dst, b, h) do { _Pragma("unroll") for (int m = 0; m < 4; ++m) _Pragma("unroll") for (int k = 0; k < 2; ++k) dst[m][k] = *(const PG8_LAS bf16x8*)(lds + PG8_SA(b, h) + aoff + m * 2048 + k * 1024); } while (0)
#define PG8_LDB(dst, b, h) do { _Pragma("unroll") for (int n = 0; n < 2; ++n) _Pragma("unroll") for (int k = 0; k < 2; ++k) dst[n][k] = *(const PG8_LAS bf16x8*)(lds + PG8_SB(b, h) + boff + n * 2048 + k * 1024); } while (0)
#define PG8_MMA(ai, bj, At, Bt) do { __builtin_amdgcn_s_setprio(1); _Pragma("unroll") for (int m = 0; m < 4; ++m) _Pragma("unroll") for (int n = 0; n < 2; ++n) _Pragma("unroll") for (int k = 0; k < 2; ++k) \
        acc[ai][bj][m][n] = __builtin_amdgcn_mfma_f32_16x16x32_bf16(Bt[n][k], At[m][k], acc[ai][bj][m][n], 0, 0, 0); __builtin_amdgcn_s_setprio(0); } while (0)
#define PG8_WAIT_V(n) asm volatile("s_waitcnt vmcnt(" #n ")" ::: "memory")
#define PG8_WAIT_L(n) asm volatile("s_waitcnt lgkmcnt(" #n ")" ::: "memory")
#define PG8_BAR __builtin_amdgcn_s_barrier()
#define PG8_SCHED __builtin_amdgcn_sched_barrier(0)
    Unit cur, nxt; int ui = 0;
    if (!S.next(0, cur)) return;
    f32x4 acc[2][2][4][2];
#pragma unroll
    for (int a = 0; a < 2; ++a)
#pragma unroll
        for (int b = 0; b < 2; ++b)
#pragma unroll
            for (int m = 0; m < 4; ++m)
#pragma unroll
                for (int n = 0; n < 2; ++n) acc[a][b][m][n] = (f32x4){0.f, 0.f, 0.f, 0.f};
    bf16x8 At[4][2], B0[2][2], B1[2][2];
    const char* cA = (const char*)g.A + (size_t)cur.pm * tstep; const char* cB = (const char*)g.Bt + (size_t)cur.pn * tstep;
    S.a_ready(cur);
    if constexpr (SP2) {
        PG8_STAGE(PG8_SB(0, 0), cB, voffB); PG8_STAGE(PG8_SB(0, 1), cB + hstep, voffB); PG8_STAGE(PG8_SA(0, 0), cA, voffA); PG8_STAGE(PG8_SA(0, 1), cA + hstep, voffA);
        if (wr == 1) PG8_BAR;
        PG8_WAIT_V(2); PG8_BAR;
        PG8_STAGE(PG8_SB(1, 0), cB + kstep, voffB); PG8_STAGE(PG8_SA(1, 0), cA + kstep, voffA); PG8_STAGE(PG8_SB(1, 1), cB + hstep + kstep, voffB);
        PG8_WAIT_V(6); PG8_BAR;
    } else {
        PG8_STAGE(PG8_SB(0, 0), cB, voffB); PG8_STAGE(PG8_SA(0, 0), cA, voffA); PG8_STAGE(PG8_SB(0, 1), cB + hstep, voffB); PG8_STAGE(PG8_SA(0, 1), cA + hstep, voffA);
        if (wr == 1) PG8_BAR;
        PG8_WAIT_V(4); PG8_BAR;
        PG8_STAGE(PG8_SB(1, 0), cB + kstep, voffB); PG8_STAGE(PG8_SA(1, 0), cA + kstep, voffA); PG8_STAGE(PG8_SB(1, 1), cB + hstep + kstep, voffB);
        PG8_WAIT_V(6); PG8_BAR;
    }
    for (;;) {
        const bool has_next = S.next(ui + 1, nxt);
        const char* nA = has_next ? (const char*)g.A + (size_t)nxt.pm * tstep : cA; const char* nB = has_next ? (const char*)g.Bt + (size_t)nxt.pn * tstep : cB;
        for (int t = 0; t < nt; t += 2) {
            const bool last = (t == nt - 2);
            const char* a1 = cA + (size_t)(t + 1) * kstep;
            const char* a2 = last ? nA : cA + (size_t)(t + 2) * kstep; const char* b2 = last ? nB : cB + (size_t)(t + 2) * kstep;
            const char* a3 = a2 + kstep; const char* b3 = b2 + kstep;
            if (last && has_next) S.a_ready(nxt);
            if constexpr (SP2) {
            PG8_LDB(B0, 0, 0); PG8_LDB(B1, 0, 1); PG8_SCHED; PG8_LDA(At, 0, 0); PG8_STAGE(PG8_SA(1, 1), a1 + hstep, voffA);
            PG8_WAIT_V(8); PG8_WAIT_L(0); PG8_BAR; PG8_MMA(0, 0, At, B0); PG8_MMA(0, 1, At, B1); PG8_BAR; PG8_SCHED;
            PG8_LDA(At, 0, 1); PG8_STAGE(PG8_SB(0, 0), b2, voffB); PG8_STAGE(PG8_SB(0, 1), b2 + hstep, voffB); PG8_STAGE(PG8_SA(0, 0), a2, voffA);
            PG8_WAIT_V(8); PG8_WAIT_L(0); PG8_BAR; PG8_MMA(1, 0, At, B0); PG8_MMA(1, 1, At, B1); PG8_BAR; PG8_SCHED;
            PG8_LDB(B0, 1, 0); PG8_LDB(B1, 1, 1); PG8_SCHED; PG8_LDA(At, 1, 0); PG8_STAGE(PG8_SA(0, 1), a2 + hstep, voffA);
            PG8_WAIT_V(8); PG8_WAIT_L(0); PG8_BAR; PG8_MMA(0, 0, At, B0); PG8_MMA(0, 1, At, B1); PG8_BAR; PG8_SCHED;
            PG8_LDA(At, 1, 1); PG8_STAGE(PG8_SB(1, 0), b3, voffB); PG8_STAGE(PG8_SB(1, 1), b3 + hstep, voffB); PG8_STAGE(PG8_SA(1, 0), a3, voffA);
            PG8_WAIT_V(8); PG8_WAIT_L(0); PG8_BAR; PG8_MMA(1, 0, At, B0); PG8_MMA(1, 1, At, B1); PG8_BAR; PG8_SCHED;
            } else {
            PG8_LDB(B0, 0, 0); PG8_SCHED; PG8_LDA(At, 0, 0); PG8_STAGE(PG8_SA(1, 1), a1 + hstep, voffA);
            PG8_WAIT_L(8); PG8_BAR; PG8_WAIT_L(0); PG8_MMA(0, 0, At, B0); PG8_BAR; PG8_SCHED;
            PG8_LDB(B1, 0, 1); PG8_STAGE(PG8_SB(0, 0), b2, voffB);
            PG8_BAR; PG8_WAIT_L(0); PG8_MMA(0, 1, At, B1); PG8_BAR;
            PG8_LDA(At, 0, 1); PG8_STAGE(PG8_SA(0, 0), a2, voffA);
            PG8_BAR; PG8_WAIT_L(0); PG8_MMA(1, 0, At, B0); PG8_BAR; PG8_SCHED;
            PG8_STAGE(PG8_SB(0, 1), b2 + hstep, voffB);
            PG8_WAIT_V(6); PG8_BAR; PG8_MMA(1, 1, At, B1); PG8_BAR;
            PG8_LDB(B0, 1, 0); PG8_SCHED; PG8_LDA(At, 1, 0); PG8_STAGE(PG8_SA(0, 1), a2 + hstep, voffA);
            PG8_WAIT_L(8); PG8_BAR; PG8_WAIT_L(0); PG8_MMA(0, 0, At, B0); PG8_BAR; PG8_SCHED;
            PG8_LDB(B1, 1, 1); PG8_STAGE(PG8_SB(1, 0), b3, voffB);
            PG8_BAR; PG8_WAIT_L(0); PG8_MMA(0, 1, At, B1); PG8_BAR;
            PG8_LDA(At, 1, 1); PG8_STAGE(PG8_SA(1, 0), a3, voffA);
            PG8_BAR; PG8_WAIT_L(0); PG8_MMA(1, 0, At, B0); PG8_BAR; PG8_SCHED;
            PG8_STAGE(PG8_SB(1, 1), b3 + hstep, voffB);
            PG8_WAIT_V(6); PG8_BAR; PG8_MMA(1, 1, At, B1); PG8_BAR;
            }
        }
        if constexpr (ALIGN_EPI) { if (wr == 0) PG8_BAR; }
        if constexpr (!Epi::AFTER_DRAIN) { E(acc, cur, wr, wc, fr, fq); S.done(cur); }
        if (!has_next) break;
#pragma unroll
        for (int a = 0; a < 2; ++a)
#pragma unroll
            for (int b = 0; b < 2; ++b)
#pragma unroll
                for (int m = 0; m < 4; ++m)
#pragma unroll
                    for (int n = 0; n < 2; ++n) acc[a][b][m][n] = (f32x4){0.f, 0.f, 0.f, 0.f};
        cur = nxt; cA = nA; cB = nB; ++ui;
        if constexpr (ALIGN_EPI) { if (wr == 1) PG8_BAR; }
    }
    PG8_WAIT_V(0);
    if constexpr (!ALIGN_EPI) { if (wr == 0) PG8_BAR; }
    PG8_BAR;
    if constexpr (Epi::AFTER_DRAIN) { E.fused(acc, cur, wr, wc, fr, fq, lds, wid, lane); S.done(cur); }
#undef PG8_SA
#undef PG8_SB
#undef PG8_STAGE
#undef PG8_LDA
#undef PG8_LDB
#undef PG8_MMA
#undef PG8_WAIT_V
#undef PG8_WAIT_L
#undef PG8_BAR
#undef PG8_SCHED
}
}

using pg8::bf16_t; using pg8::bf16x8; using pg8::f32x4; using pg8::u32x4; using pg8::u32x2; using pg8::pk2;
typedef float f32x16 __attribute__((ext_vector_type(16)));
typedef float f32x2v __attribute__((ext_vector_type(2)));
typedef short s16x4v __attribute__((ext_vector_type(4)));
#define LAS3 __attribute__((address_space(3)))
typedef short s16x8 __attribute__((ext_vector_type(8)));
constexpr int DM = 1024, MP = 16384, MS = 128, MT = MP + MS, SEQ = 4096, NB = 4, DB = 8, DS = 16, PAST = 2048, LKS = 2176  , NKS = 128  , FF = 4096, NMEM = 256;
constexpr float LOG2E = 1.4426950408889634f;
constexpr float CFOX = 0.125f * LOG2E, CMEM = 0.08838834764831845f * LOG2E;
constexpr int NTHR = 512;
constexpr int LDS_BYTES = 147456, RING_BYTES = 131072, MISC_OFF = LDS_BYTES - 256;

constexpr size_t O_Y = 0, O_YS = 16777216, O_PSP = 16908288, O_PSS = 16939008, O_KP = 17000448, O_VP = 25389056, O_LFP = 33777664, O_KS = 33908736, O_VS = 33974272, O_LFS = 34039808, O_MK = 34040832, O_MV = 35089408;

constexpr size_t MiB = 1u << 20;
constexpr size_t WS_CTL = 0, CTL_BYTES = 1 * MiB;
constexpr size_t WS_SLOTS = 1 * MiB;
constexpr size_t SLOT_BANK = 69632;
constexpr size_t WS_WIN0 = 4 * MiB;
constexpr size_t WS_WINKV = 6 * MiB;
constexpr size_t WS_WOUT = 10 * MiB;
constexpr size_t WS_WUP = 14 * MiB;
constexpr size_t WS_WDN = 30 * MiB;
constexpr size_t WS_WMEM = 46 * MiB;
constexpr size_t WS_WPOOL = 50 * MiB;
constexpr size_t WS_WF = 50 * MiB + 512 * 1024;
constexpr size_t WS_MN = 51 * MiB;
constexpr size_t WS_MKVP = 53 * MiB;
constexpr size_t WS_MKS = 57 * MiB;
constexpr size_t WS_MVS = 61 * MiB;
constexpr size_t WS_XN = 65 * MiB;
constexpr size_t WS_OV = 100 * MiB;
constexpr size_t WS_HB = WS_OV;
constexpr size_t WS_MI = WS_OV;
constexpr size_t WS_MQ = WS_OV + 17 * MiB;
constexpr size_t WS_CAT = WS_OV + 34 * MiB;
constexpr size_t WS_KB = WS_OV + 67 * MiB;
constexpr size_t WS_VB = WS_OV + 84 * MiB;
constexpr size_t WS_KSB = WS_OV + 101 * MiB;
constexpr size_t WS_VSB = WS_OV + 118 * MiB;
constexpr size_t WS_SSQ = WS_OV + 135 * MiB;
constexpr size_t WS_END = WS_SSQ + 2 * MiB;
static_assert((size_t)MT * FF * 2 <= 135 * MiB, "HB fits");
constexpr int CW_Q = 64;
constexpr int CW_CNT = 1024;
constexpr int CW_BAR = 65536;

struct Params { const float* in[24]; float* out; unsigned char* ws; int ph_lo, ph_hi; };

#define MFMA32(a, b, c) __builtin_amdgcn_mfma_f32_32x32x16_bf16((a), (b), (c), 0, 0, 0)
__device__ __forceinline__ int crow(int r, int h) { return (r & 3) + 8 * (r >> 2) + 4 * h; }
__device__ __forceinline__ float bf2f(unsigned short u) { return __uint_as_float((unsigned)u << 16); }
__device__ __forceinline__ unsigned short f2bf(float f) { return (unsigned short)(pk2(f, 0.f) & 0xffffu); }
__device__ __forceinline__ size_t foff(int row, int k, int K) { return ((((size_t)(row >> 5) * (K >> 4) + (k >> 4)) * 64 + ((k >> 3) & 1) * 32 + (row & 31)) << 3) + (k & 7); }
__device__ __forceinline__ float wave_sum(float v) {
#pragma unroll
    for (int o = 1; o < 64; o <<= 1) v += __shfl_xor(v, o);
    return v;
}

__device__ __forceinline__ void transpose_item(const float* W, int K, int N, int ldw, const float* gain, bf16_t* WT, float* scr, int item, int lane) {
    const int nblk = N / 64, kb = item / nblk, nb = item % nblk, k0 = 64 * kb, n0 = 64 * nb;
    const int lr = lane >> 4, lc = 4 * (lane & 15);
    f32x4 v[16];
#pragma unroll
    for (int i = 0; i < 16; ++i) v[i] = __builtin_nontemporal_load((const f32x4*)(W + (size_t)(k0 + 4 * i + lr) * ldw + n0 + lc));
#pragma unroll
    for (int i = 0; i < 16; ++i) { const int kk = 4 * i + lr; const float gk = gain ? gain[k0 + kk] : 1.f; float* d = scr + kk * 65 + lc; d[0] = v[i].x * gk; d[1] = v[i].y * gk; d[2] = v[i].z * gk; d[3] = v[i].w * gk; }
    asm volatile("s_waitcnt lgkmcnt(0)" ::: "memory");
    const int c = lane & 7;
#pragma unroll
    for (int j = 0; j < 8; ++j) { const int n = (lane >> 3) + 8 * j; const float* s = scr + (8 * c) * 65 + n;
        u32x4 o; o.x = pk2(s[0 * 65], s[1 * 65]); o.y = pk2(s[2 * 65], s[3 * 65]); o.z = pk2(s[4 * 65], s[5 * 65]); o.w = pk2(s[6 * 65], s[7 * 65]);
        *(u32x4*)(WT + (size_t)(n0 + n) * K + k0 + 8 * c) = o; }
    asm volatile("s_waitcnt lgkmcnt(0)" ::: "memory");
}
__device__ __forceinline__ void norm_row_to_bf16(const float* xrow, bf16_t* orow, int lane, int frow = -1) {
    const f32x4* xr = (const f32x4*)xrow + lane;
    f32x4 v[4]; float s = 0.f;
#pragma unroll
    for (int j = 0; j < 4; ++j) { v[j] = __builtin_nontemporal_load(xr + 64 * j); s += (v[j].x * v[j].x + v[j].y * v[j].y) + (v[j].z * v[j].z + v[j].w * v[j].w); }
    const float rs = 1.f / sqrtf(wave_sum(s) * (1.f / 1024.f) + 1e-6f);
    u32x2* o8 = (u32x2*)orow + lane;
#pragma unroll
    for (int j = 0; j < 4; ++j) { u32x2 w; w.x = pk2(v[j].x * rs, v[j].y * rs); w.y = pk2(v[j].z * rs, v[j].w * rs);
        if (frow < 0) o8[64 * j] = w; else *(u32x2*)(orow + foff(frow, 256 * j + 4 * lane, 1024)) = w; }
}
__device__ __forceinline__ void cvt_rows(const float* src, bf16_t* dst, size_t nchunks  , int chunks_per_row, int rpb, int dpb, size_t gtid, size_t gn) {
    for (size_t c = gtid; c < nchunks; c += gn) {
        const size_t r = c / chunks_per_row; const int cc = (int)(c % chunks_per_row);
        const size_t dr = (r / rpb) * dpb + (r % rpb);
        const f32x4 a = __builtin_nontemporal_load((const f32x4*)(src + c * 8)), b = __builtin_nontemporal_load((const f32x4*)(src + c * 8 + 4));
        u32x4 w; w.x = pk2(a.x, a.y); w.y = pk2(a.z, a.w); w.z = pk2(b.x, b.y); w.w = pk2(b.z, b.w);
        *(u32x4*)(dst + (dr * chunks_per_row + cc) * 8) = w;
    }
}

template <bool AFRAG = true>
__device__ __forceinline__ void skinny_gemm(const bf16_t* A, const bf16_t* Bt, int K_, int row0, int col0, float* red, f32x4 (&o)[2]) {
    const int tid = tidx(), w = tid >> 6, lane = tid & 63, r32 = lane & 31, h = lane >> 5, kg = w & 3, rh = w >> 2;
    int K = K_; asm volatile("" : "+s"(K));
    const int nch = K >> 10;
    unsigned char* Bs = (unsigned char*)red;
    const bf16x8* ap = (const bf16x8*)A + ((size_t)((row0 >> 5) + 2 * rh) * (K >> 4) + 16 * kg) * 64 + lane;
    const size_t rbs = (size_t)(K >> 4) * 64;
    const bf16_t* apr = A + (size_t)(row0 + 64 * rh + r32) * K + 256 * kg + 8 * h;
    f32x16 acc[2];
#pragma unroll
    for (int i = 0; i < 2; ++i)
#pragma unroll
        for (int r = 0; r < 16; ++r) acc[i][r] = 0.f;
    u32x4 br[8];
#define SK_BLOAD(ch) do { _Pragma("unroll") for (int i_ = 0; i_ < 8; ++i_) { const int idx_ = tid + NTHR * i_; br[i_] = *(const u32x4*)(Bt + (size_t)(col0 + (idx_ >> 7)) * K + (ch) * 1024 + (idx_ & 127) * 8); } } while (0)
#define SK_ALOAD(dst, ch, hf) do { _Pragma("unroll") for (int ks_ = 0; ks_ < 8; ++ks_) _Pragma("unroll") for (int rb_ = 0; rb_ < 2; ++rb_) \
        dst[ks_][rb_] = AFRAG ? ap[rb_ * rbs + (size_t)((ch) * 64 + (hf) * 8 + ks_) * 64] : *(const bf16x8*)(apr + (size_t)rb_ * 32 * K + (ch) * 1024 + (hf) * 128 + 16 * ks_); } while (0)
#define SK_COMP(src, hf) do { _Pragma("unroll") for (int ks_ = 0; ks_ < 8; ++ks_) { const bf16x8 b_ = *(const bf16x8*)(Bs + r32 * 2064 + (256 * kg + (hf) * 128 + 16 * ks_ + 8 * h) * 2); \
        _Pragma("unroll") for (int rb_ = 0; rb_ < 2; ++rb_) acc[rb_] = MFMA32(b_, src[ks_][rb_], acc[rb_]); } } while (0)
    bf16x8 a0[8][2];
    SK_BLOAD(0);
#pragma nounroll
    for (int ch = 0; ch < nch; ++ch) {
        SK_ALOAD(a0, ch, 0);
        __syncthreads();
#pragma unroll
        for (int i = 0; i < 8; ++i) { const int idx = tid + NTHR * i; *(u32x4*)(Bs + (idx >> 7) * 2064 + (idx & 127) * 16) = br[i]; }
        __syncthreads();
        if (ch + 1 < nch) SK_BLOAD(ch + 1);
        SK_COMP(a0, 0);
        SK_ALOAD(a0, ch, 1);
        SK_COMP(a0, 1);
    }
#undef SK_BLOAD
#undef SK_ALOAD
#undef SK_COMP
    __syncthreads();
#pragma unroll
    for (int rb = 0; rb < 2; ++rb)
#pragma unroll
        for (int r = 0; r < 16; ++r) red[((kg * 4 + 2 * rh + rb) * 16 + r) * 64 + lane] = acc[rb][r];
    __syncthreads();
    const int rbo = w >> 1, rbase = 8 * (w & 1);
    float v[8];
#pragma unroll
    for (int i = 0; i < 8; ++i) { float s = 0.f;
#pragma unroll
        for (int q = 0; q < 4; ++q) s += red[((q * 4 + rbo) * 16 + rbase + i) * 64 + lane];
        v[i] = s; }
    o[0] = (f32x4){v[0], v[1], v[2], v[3]}; o[1] = (f32x4){v[4], v[5], v[6], v[7]};
    __syncthreads();
}
__device__ __forceinline__ void skinny_rowsum(float s, float* tmp  , float* part  ) {
    const int tid = tidx(), w = tid >> 6, lane = tid & 63, r32 = lane & 31, h = lane >> 5;
    s += __shfl_xor(s, 32);
    if (h == 0) tmp[(w & 1) * 128 + 32 * (w >> 1) + r32] = s;
    __syncthreads();
    if (tid < 128) part[tid] = tmp[tid] + tmp[128 + tid];
    __syncthreads();
}
__device__ __forceinline__ void row_exchange(float* slots  , unsigned* cnt, int nparts, int part, int rows, const float* partL, float* totL) {
    const int tid = tidx(), lane = tid & 63, wid = tid >> 6;
    if (tid < rows) __hip_atomic_store(slots + (size_t)tid * nparts + part, partL[tid], __ATOMIC_RELAXED, __HIP_MEMORY_SCOPE_AGENT);
    asm volatile("s_waitcnt vmcnt(0)" ::: "memory");
    if (lane == 0) __hip_atomic_fetch_add(cnt, 1u, __ATOMIC_RELAXED, __HIP_MEMORY_SCOPE_AGENT);
    if (wid == 0) {
        unsigned spins = 0; const unsigned want = 8u * (unsigned)nparts;
        for (;;) {
            if ((unsigned)__builtin_amdgcn_readfirstlane(__hip_atomic_load(cnt, __ATOMIC_RELAXED, __HIP_MEMORY_SCOPE_AGENT)) >= want) break;
            if (++spins > (1u << 22)) break;
            __builtin_amdgcn_s_sleep(2);
        }
        __builtin_amdgcn_fence(__ATOMIC_ACQUIRE, "agent");
    }
    asm volatile("s_waitcnt vmcnt(0) lgkmcnt(0)" ::: "memory");
    __syncthreads();
    if (tid < rows) { float t = 0.f; for (int q = 0; q < nparts; ++q) t += __hip_atomic_load(slots + (size_t)tid * nparts + q, __ATOMIC_RELAXED, __HIP_MEMORY_SCOPE_AGENT); totL[tid] = t; }
    __syncthreads();
}
__device__ __forceinline__ void skinny_norm(f32x4 (&o)[2], int part, const float* base, float* out, bf16_t* xn, float* ssq_s, const float* gain, float* slots1, unsigned* cnt1, float* ldsf) {
    const int tid = tidx(), w = tid >> 6, lane = tid & 63, r32 = lane & 31, h = lane >> 5;
    float* tmp = ldsf; float* partL = ldsf + 256; float* totL = ldsf + 384;
    const int row = 32 * (w >> 1) + r32; const int c0 = part * 32 + 16 * (w & 1) + 4 * h;
    float s = 0.f;
#pragma unroll
    for (int g = 0; g < 2; ++g) s += (o[g].x * o[g].x + o[g].y * o[g].y) + (o[g].z * o[g].z + o[g].w * o[g].w);
    skinny_rowsum(s, tmp, partL);
    row_exchange(slots1, cnt1, 32, part, 128, partL, totL);
    const float rs1 = 1.0f / sqrtf(totL[row] * (1.0f / 1024.0f) + 1e-6f);
    f32x4 x1[2]; float s2 = 0.f;
#pragma unroll
    for (int g = 0; g < 2; ++g) { const int c = c0 + 8 * g; const f32x4 gv = *(const f32x4*)(gain + c); const f32x4 bs = *(const f32x4*)(base + (size_t)row * 1024 + c); x1[g] = bs + o[g] * gv * rs1;
        s2 += (x1[g].x * x1[g].x + x1[g].y * x1[g].y) + (x1[g].z * x1[g].z + x1[g].w * x1[g].w);
        *(f32x4*)(out + (size_t)row * 1024 + c) = x1[g];
        if (xn) { u32x2 wv; wv.x = pk2(x1[g].x, x1[g].y); wv.y = pk2(x1[g].z, x1[g].w); *(u32x2*)(xn + foff(row, c, 1024)) = wv; } }
    if (xn) { __syncthreads(); skinny_rowsum(s2, tmp, partL); if (tid < 128) ssq_s[tid * 32 + part] = partL[tid]; }
    __syncthreads();
}
__device__ __forceinline__ float sample_rs(const float* ssq_s, int row) {
    const f32x4* q = (const f32x4*)(ssq_s + row * 32); float t = 0.f;
#pragma unroll
    for (int i = 0; i < 8; ++i) { const f32x4 v = q[i]; t += (v.x + v.y) + (v.z + v.w); }
    return 1.0f / sqrtf(t * (1.0f / 1024.0f) + 1e-6f);
}
__device__ __forceinline__ void panel_rs(const float* ssq, int pm, float* rsL) {
    const int tid = tidx();
    if (tid < 256) { const f32x4* q = (const f32x4*)(ssq + (size_t)(pm * 256 + tid) * 16); float t = 0.f;
#pragma unroll
        for (int i = 0; i < 4; ++i) { const f32x4 v = q[i]; t += (v.x + v.y) + (v.z + v.w); }
        rsL[tid] = 1.0f / sqrtf(t * (1.0f / 1024.0f) + 1e-6f); }
    __syncthreads();
}

__device__ __forceinline__ int vpos(int row) { return (row & ~12) | ((row & 4) << 1) | ((row & 8) >> 1); }
__device__ __forceinline__ void fox_bias(float* biasL, float* wsum, const float* s1, int n1, const float* s2, int n, int npad);
template <int HD, bool FOX, bool F32KV = false>
__device__ __forceinline__ void attn_unit(unsigned char* lds, const bf16_t* Q, int ldq, int nq_valid, const bf16_t* Kp, const bf16_t* Vp, int ldk, int n_keys, int qpos0,
                                          const float* biasL, bf16_t* O, int ldo, const float* Kf = nullptr, const float* Vf = nullptr, int nf32 = 0, int frow0 = -1, int fcol0 = 0,
                                          const float* fb_s1 = nullptr, int fb_n1 = 0, const float* fb_s2 = nullptr, int fb_npad = 0, float* fb_wsum = nullptr) {
    constexpr int KT = (HD == 64) ? 128 : 64, NTT = KT / 32, NKS = KT / 16;
    constexpr int KP = HD * 2 + 16, VP = HD * 2 + 64, KBY = KT * KP, VBY = KT * VP, BUF = KBY + VBY;
    constexpr int CH = HD / 8, NL = (KT * CH) / NTHR, ND = HD / 16, NO = HD / 32; constexpr bool DEEP = (HD == 64) && !F32KV && (KT == 64);
    const int tid = tidx(), w = __builtin_amdgcn_readfirstlane(tid >> 6), lane = tid & 63, r32 = lane & 31, h = lane >> 5;
    int qrow = 32 * w + r32; if (qrow >= nq_valid) qrow = nq_valid - 1;
    bf16x8 qf[ND];
#pragma unroll
    for (int d0 = 0; d0 < ND; ++d0) qf[d0] = *(const bf16x8*)(Q + (size_t)qrow * ldq + 16 * d0 + 8 * h);
    const bool wave_active = (32 * w < nq_valid);
    const int qpos = qpos0 + 32 * w + r32;
    f32x16 o[NO];
#pragma unroll
    for (int i = 0; i < NO; ++i)
#pragma unroll
        for (int r = 0; r < 16; ++r) o[i][r] = 0.f;
    float m_run = -1e30f, l_run = 0.f;
    const int NT = (n_keys + KT - 1) / KT;
    u32x4 krA[NL], vrA[NL], krB[NL], vrB[NL]; f32x4 kraw[2 * NL], vraw[2 * NL];
#define ATT_GLOAD(t, kr, vr) do { if (F32KV && (t) < nf32) { _Pragma("unroll") for (int i_ = 0; i_ < NL; ++i_) { const int idx_ = tid + NTHR * i_, row_ = idx_ / CH, ch_ = idx_ % CH; const size_t go_ = (size_t)((t) * KT + row_) * 512 + ch_ * 8; \
        kraw[2 * i_] = __builtin_nontemporal_load((const f32x4*)(Kf + go_)); kraw[2 * i_ + 1] = __builtin_nontemporal_load((const f32x4*)(Kf + go_ + 4)); vraw[2 * i_] = __builtin_nontemporal_load((const f32x4*)(Vf + go_)); vraw[2 * i_ + 1] = __builtin_nontemporal_load((const f32x4*)(Vf + go_ + 4)); } } else { \
        _Pragma("unroll") for (int i_ = 0; i_ < NL; ++i_) { const int idx_ = tid + NTHR * i_, row_ = idx_ / CH, ch_ = idx_ % CH; const size_t go_ = (size_t)(((t) - nf32) * KT + row_) * ldk + ch_ * 8; \
        kr[i_] = *(const u32x4*)(Kp + go_); vr[i_] = *(const u32x4*)(Vp + go_); } } } while (0)
#define ATT_LWRITE(buf, t, kr, vr) do { if (F32KV && (t) < nf32) { _Pragma("unroll") for (int i_ = 0; i_ < NL; ++i_) { \
        kr[i_].x = pk2(kraw[2 * i_].x, kraw[2 * i_].y); kr[i_].y = pk2(kraw[2 * i_].z, kraw[2 * i_].w); kr[i_].z = pk2(kraw[2 * i_ + 1].x, kraw[2 * i_ + 1].y); kr[i_].w = pk2(kraw[2 * i_ + 1].z, kraw[2 * i_ + 1].w); \
        vr[i_].x = pk2(vraw[2 * i_].x, vraw[2 * i_].y); vr[i_].y = pk2(vraw[2 * i_].z, vraw[2 * i_].w); vr[i_].z = pk2(vraw[2 * i_ + 1].x, vraw[2 * i_ + 1].y); vr[i_].w = pk2(vraw[2 * i_ + 1].z, vraw[2 * i_ + 1].w); } } \
        unsigned char* kb_ = lds + (buf) * BUF; unsigned char* vb_ = kb_ + KBY; _Pragma("unroll") for (int i_ = 0; i_ < NL; ++i_) { const int idx_ = tid + NTHR * i_, row_ = idx_ / CH, ch_ = idx_ % CH; \
        *(u32x4*)(kb_ + row_ * KP + ch_ * 16) = kr[i_]; *(u32x4*)(vb_ + row_ * VP + ch_ * 16) = vr[i_]; } } while (0)
#define ATT_COMPUTE(TT_) do { const int t = (TT_); \
        const bool doit = wave_active && (!FOX || (t * KT <= qpos0 + 32 * w + 31)); \
        if (doit) { \
            const unsigned char* Kb = lds + (t & 1) * BUF; const unsigned char* Vb = Kb + KBY; \
            f32x16 p[NTT]; \
_Pragma("unroll") \
            for (int tt = 0; tt < NTT; ++tt) { \
                f32x16 c; \
                if (FOX) { \
_Pragma("unroll") \
                    for (int g = 0; g < 4; ++g) { const f32x4 bv = *(const f32x4*)(biasL + t * KT + 32 * tt + 8 * g + 4 * h); c[4 * g] = bv.x; c[4 * g + 1] = bv.y; c[4 * g + 2] = bv.z; c[4 * g + 3] = bv.w; } \
                } else { \
_Pragma("unroll") \
                    for (int r = 0; r < 16; ++r) c[r] = 0.f; \
                } \
_Pragma("unroll") \
                for (int d0 = 0; d0 < ND; ++d0) { const bf16x8 a = *(const bf16x8*)(Kb + (32 * tt + r32) * KP + (16 * d0 + 8 * h) * 2); c = MFMA32(a, qf[d0], c); } \
                p[tt] = c; \
            } \
            if (FOX && (t * KT + KT - 1 > qpos0 + 32 * w)) { \
                const int qrel = qpos - t * KT - 4 * h; \
_Pragma("unroll") \
                for (int tt = 0; tt < NTT; ++tt) \
_Pragma("unroll") \
                    for (int r = 0; r < 16; ++r) { if (32 * tt + (r & 3) + 8 * (r >> 2) > qrel) p[tt][r] = -__builtin_inff(); } \
            } \
            float mx = 0.f; \
_Pragma("unroll") \
            for (int tt = 0; tt < NTT; ++tt) { float ma = fmaxf(fmaxf(p[tt][0], p[tt][1]), p[tt][2]); \
_Pragma("unroll") \
                for (int r = 3; r < 15; r += 2) ma = fmaxf(fmaxf(ma, p[tt][r]), p[tt][r + 1]); \
                ma = fmaxf(ma, p[tt][15]); mx = tt == 0 ? ma : fmaxf(mx, ma); } \
            { auto rr = __builtin_amdgcn_permlane32_swap(__float_as_uint(mx), __float_as_uint(mx), false, false); mx = fmaxf(__uint_as_float(rr[0]), __uint_as_float(rr[1])); } \
            if (__any(mx > m_run + 20.0f)) { \
                const float mnew = fmaxf(m_run, mx); const float alpha = __builtin_amdgcn_exp2f(m_run - mnew); \
                l_run *= alpha; m_run = mnew; \
_Pragma("unroll") \
                for (int i = 0; i < NO; ++i) o[i] = o[i] * alpha; \
            } \
            f32x2v ls2 = (f32x2v){0.f, 0.f}; const f32x2v nm2 = (f32x2v){-m_run, -m_run}; \
_Pragma("unroll") \
            for (int tt = 0; tt < NTT; ++tt) \
_Pragma("unroll") \
                for (int r = 0; r < 16; r += 2) { f32x2v x = (f32x2v){p[tt][r], p[tt][r + 1]} + nm2; x.x = __builtin_amdgcn_exp2f(x.x); x.y = __builtin_amdgcn_exp2f(x.y); p[tt][r] = x.x; p[tt][r + 1] = x.y; ls2 += x; } \
            l_run += ls2.x + ls2.y; \
_Pragma("unroll") \
            for (int ks = 0; ks < NKS; ++ks) { \
                const int tt = ks >> 1, s = ks & 1; \
                u32x4 pw; pw.x = pk2(p[tt][8 * s + 0], p[tt][8 * s + 1]); pw.y = pk2(p[tt][8 * s + 2], p[tt][8 * s + 3]); pw.z = pk2(p[tt][8 * s + 4], p[tt][8 * s + 5]); pw.w = pk2(p[tt][8 * s + 6], p[tt][8 * s + 7]); \
                const bf16x8 pb = __builtin_bit_cast(bf16x8, pw); \
_Pragma("unroll") \
                for (int db = 0; db < NO; ++db) { \
                    const LAS3 unsigned char* vp = (const LAS3 unsigned char*)Vb + (32 * tt + 16 * s + 4 * h + ((lane & 15) >> 2)) * VP + 64 * db + 8 * (4 * ((lane >> 4) & 1) + (lane & 3)); \
                    const s16x4v lo = __builtin_amdgcn_ds_read_tr16_b64_v4i16((LAS3 s16x4v*)vp), hi = __builtin_amdgcn_ds_read_tr16_b64_v4i16((LAS3 s16x4v*)(vp + 8 * VP)); \
                    const bf16x8 av = (bf16x8){lo[0], lo[1], lo[2], lo[3], hi[0], hi[1], hi[2], hi[3]}; \
                    o[db] = MFMA32(av, pb, o[db]); \
                } \
            } \
        } \
    } while (0)
    ATT_GLOAD(0, krA, vrA);
    if (FOX) fox_bias((float*)biasL, fb_wsum, fb_s1, fb_n1, fb_s2, n_keys, fb_npad);
    __syncthreads();
    ATT_LWRITE(0, 0, krA, vrA);
    __syncthreads();
    if (DEEP) {
        if (1 < NT) ATT_GLOAD(1, krA, vrA);
        for (int tl = 0; tl < NT; tl += 2) {
            if (tl + 2 < NT) ATT_GLOAD(tl + 2, krB, vrB);
            ATT_COMPUTE(tl);
            if (tl + 1 < NT) ATT_LWRITE((tl + 1) & 1, tl + 1, krA, vrA);
            __syncthreads();
            if (tl + 1 < NT) {
                if (tl + 3 < NT) ATT_GLOAD(tl + 3, krA, vrA);
                ATT_COMPUTE(tl + 1);
                if (tl + 2 < NT) ATT_LWRITE(tl & 1, tl + 2, krB, vrB);
                __syncthreads();
            }
        }
    } else {
        for (int tl = 0; tl < NT; ++tl) {
            if (tl + 1 < NT) ATT_GLOAD(tl + 1, krA, vrA);
            ATT_COMPUTE(tl);
            if (tl + 1 < NT) ATT_LWRITE((tl + 1) & 1, tl + 1, krA, vrA);
            __syncthreads();
        }
    }
#undef ATT_COMPUTE
#undef ATT_GLOAD
#undef ATT_LWRITE
    const float lt = l_run + __shfl_xor(l_run, 32);
    const float inv = 1.0f / lt;
    if (32 * w + r32 < nq_valid) {
        bf16_t* op = O + (size_t)(32 * w + r32) * ldo;
#pragma unroll
        for (int db = 0; db < NO; ++db)
#pragma unroll
            for (int g = 0; g < 4; ++g) { u32x2 wv; wv.x = pk2(o[db][4 * g] * inv, o[db][4 * g + 1] * inv); wv.y = pk2(o[db][4 * g + 2] * inv, o[db][4 * g + 3] * inv);
                if (frow0 < 0) *(u32x2*)(op + 32 * db + 8 * g + 4 * h) = wv; else *(u32x2*)(O + foff(frow0 + 32 * w + r32, fcol0 + 32 * db + 8 * g + 4 * h, 1024)) = wv; }
    }
}

__device__ __forceinline__ void fox_bias(float* biasL, float* wsum  , const float* s1, int n1, const float* s2, int n, int npad) {
    const int tid = tidx(), lane = tid & 63, w = tid >> 6;
    float v[9]; float run = 0.f;
#pragma unroll
    for (int i = 0; i < 9; ++i) { const int p = tid * 9 + i; float x = 0.f; if (p < n) x = (p < n1) ? s1[(size_t)p * 8] : s2[(size_t)(p - n1) * 8]; run += x; v[i] = run; }
    float incl = run;
#pragma unroll
    for (int off = 1; off < 64; off <<= 1) { const float y = __shfl_up(incl, off); if (lane >= off) incl += y; }
    if (lane == 63) wsum[w] = incl;
    __syncthreads();
    float base = incl - run;
    for (int ww = 0; ww < w; ++ww) base += wsum[ww];
#pragma unroll
    for (int i = 0; i < 9; ++i) { const int p = tid * 9 + i; if (p < npad) biasL[p] = (p < n) ? -(base + v[i]) * LOG2E : 0.f; }
    __syncthreads();
}

__device__ __forceinline__ void pool_unit(unsigned char* lds, const Params& p, int unit) {
    const int tid = tidx(), w = tid >> 6, lane = tid & 63, r32 = lane & 31, h = lane >> 5;
    constexpr int XP = 272;
    unsigned char* X = lds; unsigned char* Ap = lds + 144 * XP;
    const bf16_t* MI = (const bf16_t*)(p.ws + WS_MI); bf16_t* CAT = (bf16_t*)(p.ws + WS_CAT); const bf16_t* WpT = (const bf16_t*)(p.ws + WS_WPOOL);
    const float* scale = p.in[16];
    int g, b, t0, nrows, rowbase; bool sample;
    if (unit < 512) { const int tile = unit >> 2; g = unit & 3; b = tile >> 5; t0 = (tile & 31) * 128; nrows = 128; rowbase = b * SEQ; sample = false; }
    else { const int s = unit - 512; b = s >> 2; g = s & 3; t0 = 0; nrows = 16; rowbase = MP + b * DS; sample = true; }
    const int win = 2 << g;
    for (int idx = tid; idx < (15 + nrows) * 16; idx += NTHR) {
        const int j = idx >> 4, ch = idx & 15; const int t = t0 - 15 + j; u32x4 v = (u32x4){0u, 0u, 0u, 0u};
        if (!sample) { if (t >= 0) v = *(const u32x4*)(MI + (size_t)(rowbase + t) * 512 + g * 128 + ch * 8); }
        else if (j < 15) { const float* cp = p.in[2] + ((size_t)(b * 15 + j) * 512 + g * 128 + ch * 8); const f32x4 a = *(const f32x4*)cp, c = *(const f32x4*)(cp + 4);
            v.x = pk2(a.x, a.y); v.y = pk2(a.z, a.w); v.z = pk2(c.x, c.y); v.w = pk2(c.z, c.w); }
        else v = *(const u32x4*)(MI + (size_t)(rowbase + (j - 15)) * 512 + g * 128 + ch * 8);
        *(u32x4*)(X + j * XP + ch * 16) = v;
    }
    __syncthreads();
    if (sample) { for (int idx = tid; idx < 15 * 128; idx += NTHR) { const int i = idx >> 7, c = idx & 127; p.out[O_PSS + (size_t)(b * 15 + i) * 512 + g * 128 + c] = bf2f(*(const unsigned short*)(X + (16 + i) * XP + c * 2)); } }
    else if (t0 == SEQ - 128) { for (int idx = tid; idx < 15 * 128; idx += NTHR) { const int i = idx >> 7, c = idx & 127; p.out[O_PSP + (size_t)(b * 15 + i) * 512 + g * 128 + c] = bf2f(*(const unsigned short*)(X + (128 + i) * XP + c * 2)); } }
    {
        const int c = tid & 127, r0 = (tid >> 7) * 32;
        if (r0 < nrows) {
            const int nr = (nrows - r0) < 32 ? (nrows - r0) : 32;
            float s = 0.f;
            for (int j = 1; j < win; ++j) s += bf2f(*(const unsigned short*)(X + (15 + r0 - j) * XP + c * 2));
            for (int t = r0; t < r0 + nr; ++t) {
                const float xv = bf2f(*(const unsigned short*)(X + (15 + t) * XP + c * 2)); s += xv;
                int cnt = win; if (!sample) { const int ta = t0 + t + 1; cnt = ta < win ? ta : win; }
                const float pooled = s / (float)cnt - xv;
                *(unsigned short*)(Ap + t * XP + c * 2) = f2bf(pooled);
                s -= bf2f(*(const unsigned short*)(X + (15 + t - (win - 1)) * XP + c * 2));
            }
        }
    }
    __syncthreads();
    {
        const int tb = w & 3, dh = w >> 2;
        if (32 * tb < nrows) {
            f32x16 acc[2];
#pragma unroll
            for (int i = 0; i < 2; ++i)
#pragma unroll
                for (int r = 0; r < 16; ++r) acc[i][r] = 0.f;
#pragma unroll
            for (int ks = 0; ks < 8; ++ks) {
                const bf16x8 bfr = *(const bf16x8*)(Ap + (32 * tb + r32) * XP + (16 * ks + 8 * h) * 2);
#pragma unroll
                for (int db = 0; db < 2; ++db) { const bf16x8 a = *(const bf16x8*)(WpT + ((size_t)(g * 128 + 64 * dh + 32 * db + r32) * 128 + 16 * ks + 8 * h)); acc[db] = MFMA32(a, bfr, acc[db]); }
            }
            const int t = 32 * tb + r32;
            if (t < nrows) {
                bf16_t* op = CAT + (size_t)(rowbase + t0 + t) * 1024 + g * 128; bf16_t* opf = CAT + (size_t)MP * 1024;
#pragma unroll
                for (int db = 0; db < 2; ++db)
#pragma unroll
                    for (int q = 0; q < 4; ++q) { const int d = 64 * dh + 32 * db + 8 * q + 4 * h; const f32x4 sc = *(const f32x4*)(scale + g * 128 + d);
                        u32x2 wv; wv.x = pk2(acc[db][4 * q] * sc.x, acc[db][4 * q + 1] * sc.y); wv.y = pk2(acc[db][4 * q + 2] * sc.z, acc[db][4 * q + 3] * sc.w);
                        if (!sample) *(u32x2*)(op + d) = wv; else *(u32x2*)(opf + foff(b * DS + t, g * 128 + d, 1024)) = wv; }
            }
        }
    }
    __syncthreads();
}

__device__ __forceinline__ void mem_unit(unsigned char* lds, const Params& p, int l, int unit) {
    const bf16_t* MQ = (const bf16_t*)(p.ws + WS_MQ); bf16_t* CAT = (bf16_t*)(p.ws + WS_CAT);
    size_t row0; int hd, nq, ldk; const bf16_t* k; const bf16_t* v;
    if (unit < 256) {
        const int b = unit >> 6, qb = unit & 15; hd = (unit >> 4) & 3; row0 = (size_t)b * SEQ + qb * 256; nq = 256; ldk = 1024;
        k = (const bf16_t*)(p.ws + WS_MKVP) + (size_t)l * 1024 * 1024 + (size_t)b * NMEM * 1024 + hd * 128; v = k + 512;
    } else {
        const int s = unit - 256, b = s >> 2; hd = s & 3; row0 = (size_t)MP + b * DS; nq = DS; ldk = 512;
        k = (const bf16_t*)(p.ws + WS_MKS) + ((size_t)l * DB * NMEM + (size_t)b * NMEM) * 512 + hd * 128;
        v = (const bf16_t*)(p.ws + WS_MVS) + ((size_t)l * DB * NMEM + (size_t)b * NMEM) * 512 + hd * 128;
    }
    if (unit < 256) attn_unit<128, false>(lds, MQ + row0 * 512 + hd * 128, 512, nq, k, v, ldk, NMEM, 0, nullptr, CAT + row0 * 1024 + 512 + hd * 128, 1024);
    else attn_unit<128, false>(lds, MQ + row0 * 512 + hd * 128, 512, nq, k, v, ldk, NMEM, 0, nullptr, CAT + (size_t)MP * 1024, 1024, nullptr, nullptr, 0, (int)(row0 - MP), 512 + hd * 128);
}
__device__ __forceinline__ void fox_unit(unsigned char* lds, const Params& p, int unit) {
    const bf16_t* MI = (const bf16_t*)(p.ws + WS_MI); bf16_t* CAT = (bf16_t*)(p.ws + WS_CAT);
    float* biasL = (float*)(lds + 86016); float* wsum = (float*)(lds + 86016 + 18432);
    size_t row0; int hd, nq, nk, n1, npad, qpos0, nf32 = 0; const float* s1; const float* s2; const bf16_t* k; const bf16_t* v; const float* kf = nullptr; const float* vf = nullptr;
    if (unit < 512) {
        const int qb = 15 - (unit >> 5), bh = unit & 31, b = bh >> 3; hd = bh & 7; const size_t rowb = (size_t)b * SEQ; nk = (qb + 1) * 256; n1 = nk; npad = nk; nq = 256; qpos0 = qb * 256;
        row0 = rowb + qb * 256; s1 = p.out + O_LFP + rowb * 8 + hd; s2 = s1;
        k = (const bf16_t*)(p.ws + WS_KB) + rowb * 512 + hd * 64; v = (const bf16_t*)(p.ws + WS_VB) + rowb * 512 + hd * 64;
    } else {
        const int s = unit - 512, b = s >> 3; hd = s & 7; row0 = (size_t)MP + b * DS; nk = PAST + DS; n1 = PAST; npad = LKS; nq = DS; qpos0 = PAST;
        s1 = p.in[5] + (size_t)b * PAST * 8 + hd; s2 = p.out + O_LFS + (size_t)b * DS * 8 + hd;
        k = (const bf16_t*)(p.ws + WS_KSB) + (size_t)b * NKS * 512 + hd * 64; v = (const bf16_t*)(p.ws + WS_VSB) + (size_t)b * NKS * 512 + hd * 64;
        kf = p.in[3] + (size_t)b * PAST * 512 + hd * 64; vf = p.in[4] + (size_t)b * PAST * 512 + hd * 64; nf32 = PAST / 128;
    }
    const bool smp = unit >= 512;
    if (!smp) attn_unit<64, true, false>(lds, MI + row0 * 512 + hd * 64, 512, nq, k, v, 512, nk, qpos0, biasL, CAT + row0 * 1024 + hd * 64, 1024, nullptr, nullptr, 0, -1, 0, s1, n1, s2, npad, wsum);
    else attn_unit<64, true, true>(lds, MI + row0 * 512 + hd * 64, 512, nq, k, v, 512, nk, qpos0, biasL, CAT + (size_t)MP * 1024, 1024, kf, vf, nf32, (int)(row0 - MP), hd * 64, s1, n1, s2, npad, wsum);
}

__device__ __forceinline__ void cvt_unit(unsigned char* lds, const Params& p, int unit) {
    const int tid = tidx(), lane = tid & 63, wave = __builtin_amdgcn_readfirstlane(tid >> 6);
    float* scr = (float*)(lds + wave * 16640);
    constexpr int I_SQ = 16 * 16, I_UP = 16 * 64, I_DN = 64 * 16;
    int r = unit * 8 + wave;
    const float* W; const float* gain = nullptr; bf16_t* WT; int K = 1024, N = 1024, ldw = 1024;
    if (r < I_SQ) { W = p.in[13] + 1048576; gain = p.in[9] + 1024; WT = (bf16_t*)(p.ws + WS_WINKV); }
    else if ((r -= I_SQ) < I_SQ) { W = p.in[18]; ldw = 1032; gain = p.in[17]; WT = (bf16_t*)(p.ws + WS_WINKV) + 1048576; }
    else if ((r -= I_SQ) < I_SQ) { W = p.in[14]; WT = (bf16_t*)(p.ws + WS_WOUT); }
    else if ((r -= I_SQ) < I_SQ) { W = p.in[14] + 1048576; WT = (bf16_t*)(p.ws + WS_WOUT) + 1048576; }
    else if ((r -= I_SQ) < I_UP) { W = p.in[22]; N = 4096; ldw = 4096; gain = p.in[11]; WT = (bf16_t*)(p.ws + WS_WUP); }
    else if ((r -= I_UP) < I_UP) { W = p.in[22] + 4194304; N = 4096; ldw = 4096; gain = p.in[11] + 1024; WT = (bf16_t*)(p.ws + WS_WUP) + 4194304; }
    else if ((r -= I_UP) < I_DN) { W = p.in[23]; K = 4096; WT = (bf16_t*)(p.ws + WS_WDN); }
    else { r -= I_DN; W = p.in[23] + 4194304; K = 4096; WT = (bf16_t*)(p.ws + WS_WDN) + 4194304; }
    transpose_item(W, K, N, ldw, gain, WT, scr, r, lane);
}

#define LAS __attribute__((address_space(3)))
#define XB_TMO      128
#define XB_XCNT(j)  (256  + 64 * (j))
#define XB_XSUB(j)  (1280 + 64 * (j))
#define XB_XGEN(j)  (2304 + 64 * (j))
#define XB_TOP      3328
#define XB_TOPGEN   3392
#define XCD_BAR_WORDS 3456
#define XB_SPIN_CAP (1u << 18)

__device__ __forceinline__ unsigned xb_ld(unsigned* p)              { return __hip_atomic_load(p, __ATOMIC_RELAXED, __HIP_MEMORY_SCOPE_AGENT); }
__device__ __forceinline__ unsigned xb_add(unsigned* p, unsigned v) { return __hip_atomic_fetch_add(p, v, __ATOMIC_RELAXED, __HIP_MEMORY_SCOPE_AGENT); }
__device__ __forceinline__ unsigned xb_xcc_id() { return (unsigned)__builtin_amdgcn_s_getreg((3 << 11) | 20) & 0xFu; }
#define XB_SPIN(cond, bar) do { unsigned _sp = 0; while (cond) { __builtin_amdgcn_s_sleep(1); \
    if ((++_sp & 255u) == 0u) { if (xb_ld(&(bar)[XB_TMO])) break; if (_sp > XB_SPIN_CAP) { atomicAdd(&(bar)[XB_TMO], 1u); break; } } } } while (0)

struct XcdBarrier {
    unsigned* bar; unsigned x;
    volatile LAS unsigned* st;
};

__device__ __forceinline__ XcdBarrier xcd_barrier_post(unsigned* bar, volatile LAS unsigned* st) {
    XcdBarrier b; b.bar = bar; b.x = xb_xcc_id(); b.st = st;
    if (tidx() == 0) (void)xb_add(&bar[XB_XCNT(b.x)], 1u);
    return b;
}
__device__ __forceinline__ void xcd_barrier_complete(unsigned* bar, unsigned x, unsigned& nloc, unsigned& nx) {
    const unsigned G = gridDim.x * gridDim.y * gridDim.z;
    unsigned sum, cnt, mine, sp = 0u;
    for (;;) {
        sum = 0u; cnt = 0u; mine = 0u;
#pragma unroll
        for (unsigned j = 0; j < 16; ++j) { const unsigned c = xb_ld(&bar[XB_XCNT(j)]); sum += c; cnt += (c > 0u) ? 1u : 0u; mine = (j == x) ? c : mine; }
        if (sum == G) break;
        __builtin_amdgcn_s_sleep(1);
        if ((++sp & 255u) == 0u) { if (xb_ld(&bar[XB_TMO])) break; if (sp > XB_SPIN_CAP) { atomicAdd(&bar[XB_TMO], 1u); break; } }
    }
    nloc = mine > 0u ? mine : 1u; nx = cnt > 0u ? cnt : 1u;
}

__device__ __forceinline__ void xcd_barrier(const XcdBarrier& b) {
    asm volatile("s_waitcnt vmcnt(0)" ::: "memory");
    __syncthreads();
    if (tidx() == 0) {
        unsigned* bar = b.bar;
        __builtin_amdgcn_s_waitcnt(0);
        unsigned nloc = b.st[0], nx = b.st[1];
        if (nloc == 0u) { xcd_barrier_complete(bar, b.x, nloc, nx); b.st[0] = nloc; b.st[1] = nx; }
        const unsigned old = xb_add(&bar[XB_XSUB(b.x)], 1u);
        const unsigned gen = old / nloc;
        if (old + 1u == (gen + 1u) * nloc) {
            __builtin_amdgcn_fence(__ATOMIC_RELEASE, "agent");
            asm volatile("s_waitcnt vmcnt(0)" ::: "memory");
            const unsigned og = xb_add(&bar[XB_TOP], 1u);
            const unsigned tg = og / nx;
            if (og + 1u == (tg + 1u) * nx) xb_add(&bar[XB_TOPGEN], 1u);
            else XB_SPIN(xb_ld(&bar[XB_TOPGEN]) == tg, bar);
            __builtin_amdgcn_fence(__ATOMIC_ACQUIRE, "agent");
            xb_add(&bar[XB_XGEN(b.x)], 1u);
            asm volatile("s_waitcnt vmcnt(0)" ::: "memory");
        } else {
            XB_SPIN(xb_ld(&bar[XB_XGEN(b.x)]) == gen, bar);
            __builtin_amdgcn_fence(__ATOMIC_ACQUIRE, "agent");
            asm volatile("s_waitcnt vmcnt(0)" ::: "memory");
        }
    }
    __syncthreads();
}

#ifndef ENMASK
#define ENMASK 63
#endif
#define EN(t) (((ENMASK) >> (t)) & 1)
#define IN(k) (lo <= (k) && (k) < hi)
#define SEAM(k) do { if (IN(k) && IN((k) + 1)) xcd_barrier(bar); } while (0)
template <int l>
__device__ __forceinline__ void layer_phases(const Params& p, unsigned char* lds, const XcdBarrier& bar, int lo, int hi) {
    const int tid = tidx(), lane = tid & 63, wave = __builtin_amdgcn_readfirstlane(tid >> 6);
    const int G = gridDim.x, bx = blockIdx.x;
    unsigned* ctl = (unsigned*)(p.ws + WS_CTL);
    float* slots = (float*)(p.ws + WS_SLOTS);
    int* qslot = (int*)(lds + MISC_OFF);
    float* ldsf = (float*)lds;
    PG8_LAS unsigned char* lds3 = (PG8_LAS unsigned char*)lds;
    bf16_t* XN = (bf16_t*)(p.ws + WS_XN);
    float* X = p.out + O_Y;
    float* ssq = (float*)(p.ws + WS_SSQ); float* ssq_s = ssq + (size_t)MP * 16;
    float* rsL = (float*)(lds + RING_BYTES); const PG8_LAS float* rsL3 = (const PG8_LAS float*)(lds3 + RING_BYTES);
    (void)wave; (void)ctl; (void)slots; (void)qslot;
        const int pb = 1 + 5 * l;
        if (EN(1) && IN(pb)) {
            bf16_t* MIb = (bf16_t*)(p.ws + WS_MI); bf16_t* MQb = (bf16_t*)(p.ws + WS_MQ);
            const float smi = l == 0 ? 1.f : CFOX, smq = CMEM;
            const int nsk_s = l == 0 ? 32 : 64, nsk = l == 0 ? 32 + 512 : 64 + 129;
#ifndef PROBE_SK
#define PROBE_SK 1
#endif
            for (int reps = 0; reps < PROBE_SK; ++reps)
            for (int u = bx; u < nsk; u += G) {
                f32x4 o[2];
                if (u < nsk_s) {
                    skinny_gemm(XN + (size_t)MP * DM, (const bf16_t*)(p.ws + (l == 0 ? WS_WIN0 : WS_WINKV)), 1024, 0, u * 32, ldsf, o);
                    const int w = tid >> 6, r32 = lane & 31, h = lane >> 5; const int row = 32 * (w >> 1) + r32;
                    const float rsr = l == 1 ? sample_rs(ssq_s, row) : 1.f;
#pragma unroll
                    for (int g = 0; g < 2; ++g) { const int col = u * 32 + 16 * (w & 1) + 8 * g + 4 * h; const int sec = col >> 9, cc = col & 511; const f32x4 v = o[g] * rsr;
                        if (sec < 2) { const float sc = sec == 0 ? smi : smq; u32x2 wv; wv.x = pk2(v.x * sc, v.y * sc); wv.y = pk2(v.z * sc, v.w * sc); *(u32x2*)((sec == 0 ? MIb : MQb) + (size_t)(MP + row) * 512 + cc) = wv; }
                        else { *(f32x4*)(p.out + (sec == 2 ? O_KS : O_VS) + (size_t)row * 512 + cc) = v; u32x2 wv; wv.x = pk2(v.x, v.y); wv.y = pk2(v.z, v.w);
                            *(u32x2*)((bf16_t*)(p.ws + (sec == 2 ? WS_KSB : WS_VSB)) + ((size_t)(row >> 4) * NKS + (row & 15)) * 512 + cc) = wv; } }
                } else if (l == 1) {
                    const int ug = u - 64;
                    if (ug < 128) skinny_gemm<false>(XN, (const bf16_t*)(p.ws + WS_WF), 1024, ug * 128, 0, ldsf, o);
                    else skinny_gemm<true>(XN + (size_t)MP * DM, (const bf16_t*)(p.ws + WS_WF), 1024, 0, 0, ldsf, o);
                    const int w = tid >> 6, r32 = lane & 31, h = lane >> 5; const int m = ug * 128 + 32 * (w >> 1) + r32;
                    float rsm;
                    if (m < MP) { const f32x4* q = (const f32x4*)(ssq + (size_t)m * 16); float t = 0.f;
#pragma unroll
                        for (int i = 0; i < 4; ++i) { const f32x4 v = q[i]; t += (v.x + v.y) + (v.z + v.w); }
                        rsm = 1.0f / sqrtf(t * (1.0f / 1024.0f) + 1e-6f); }
                    else rsm = sample_rs(ssq_s, m - MP);
                    if ((w & 1) == 0) { const f32x4 bfv = *(const f32x4*)(p.in[19] + 4 * h); f32x4 lf;
#pragma unroll
                        for (int e = 0; e < 4; ++e) { const float v = o[0][e] * rsm + bfv[e]; lf[e] = fminf(v, 0.f) - log1pf(expf(-fabsf(v))); }
                        if (m < MP) *(f32x4*)(p.out + O_LFP + (size_t)m * 8 + 4 * h) = lf; else *(f32x4*)(p.out + O_LFS + (size_t)(m - MP) * 8 + 4 * h) = lf; }
                } else {
                    const int v_ = u - 32, ly = v_ >> 8, rg = (v_ >> 5) & 7, cu = v_ & 31;
                    skinny_gemm((const bf16_t*)(p.ws + WS_MN), (const bf16_t*)(p.ws + WS_WMEM) + (size_t)ly * 1048576, 1024, rg * 128, cu * 32, ldsf, o);
                    const int w = tid >> 6, r32 = lane & 31, h = lane >> 5; const int row = rg * 128 + 32 * (w >> 1) + r32;
#pragma unroll
                    for (int g = 0; g < 2; ++g) { const int col = cu * 32 + 16 * (w & 1) + 8 * g + 4 * h; const f32x4 v = o[g];
                        *(f32x4*)(p.out + (col < 512 ? O_MK : O_MV) + (size_t)ly * 524288 + (size_t)row * 512 + (col & 511)) = v;
                        u32x2 wv; wv.x = pk2(v.x, v.y); wv.y = pk2(v.z, v.w); *(u32x2*)((bf16_t*)(p.ws + WS_MKVP) + (size_t)ly * 1048576 + (size_t)row * 1024 + col) = wv; }
                }
            }
            __syncthreads();
            pg8::Gemm g{XN, (const bf16_t*)(p.ws + (l == 0 ? WS_WIN0 : WS_WINKV)), MP, l == 0 ? 1024 : 2048, 1024};
            pg8::StaticOrder S; S.init(MP, g.N, G, bx);
            if (l == 1) { pg8::Unit u0; if (S.next(0, u0)) panel_rs(ssq, u0.pm, rsL); else __syncthreads(); }
            pg8::EpiProj E{MIb, MQb, (bf16_t*)(p.ws + WS_KB), (bf16_t*)(p.ws + WS_VB), p.out + O_KP, p.out + O_VP, smi, smq, l == 1 ? rsL3 : (const PG8_LAS float*)nullptr};
            pg8::gemm_phase<pg8::EpiProj, pg8::StaticOrder, true, true>(lds3, g, S, E);
#ifndef PROBE_PROJ
#define PROBE_PROJ 1
#endif
            if (PROBE_PROJ > 1 && l == 0) { __syncthreads(); pg8::gemm_phase<pg8::EpiProj, pg8::StaticOrder, true, true>(lds3, g, S, E); }
        }
        SEAM(pb);
        if (EN(2) && IN(pb + 1)) {
#ifndef PROBE_MIX
#define PROBE_MIX 1
#endif
            #ifndef PROBE_MIX_L
#define PROBE_MIX_L 1
#endif
            for (int rep = 0; rep < (l == PROBE_MIX_L ? PROBE_MIX : 1); ++rep) {
            unsigned* qc = ctl + CW_Q + 64 * (l + 2 * rep);
            const int nunits = l == 0 ? (640 + 256 + 544 + 32) : (576 + 288);
            for (;;) {
                __syncthreads();
                if (tid == 0) *qslot = (int)atomicAdd(qc, 1u);
                __syncthreads();
                const int u = *qslot;
                if (u >= nunits) break;
                if (l == 0) { const bool cv = u < 1280 && (u & 1) == 0; const int cu = u < 1280 ? (u >> 1) : u - 640;
                    if (cv) cvt_unit(lds, p, u >> 1); else if (cu >= 256 && cu < 800) pool_unit(lds, p, cu - 256); else mem_unit(lds, p, 0, cu < 256 ? cu : cu - 544); }
                else { if (u < 576) fox_unit(lds, p, u < 64 ? 512 + u : u - 64); else mem_unit(lds, p, 1, u - 576); }
            }
            }
            __syncthreads();
        }
        SEAM(pb + 1);
        if (EN(3) && IN(pb + 2)) {
            const float* bases = l == 0 ? p.in[1] : X + (size_t)MP * DM;
            const int bk = 2 * l;
            float* sl1 = slots + (size_t)bk * SLOT_BANK; unsigned* c1 = ctl + CW_CNT + bk * 80 * 64;
            const bf16_t* Wt = (const bf16_t*)(p.ws + WS_WOUT) + (size_t)l * 1048576;
            for (int u = bx; u < 32; u += G) {
                f32x4 o[2];
                skinny_gemm((const bf16_t*)(p.ws + WS_CAT) + (size_t)MP * DM, Wt, 1024, 0, u * 32, ldsf, o);
                skinny_norm(o, u, bases, X + (size_t)MP * DM, XN + (size_t)MP * DM, ssq_s, p.in[10] + l * 1024, sl1 + 65536, c1 + 64 * 64, ldsf);
            }
            __syncthreads();
            pg8::Gemm g{(const bf16_t*)(p.ws + WS_CAT), Wt, MP, 1024, 1024};
            pg8::StaticOrder S; S.init(MP, 1024, G, bx);
            if (l == 0) { pg8::EpiNorm<true, false> E{p.in[0], nullptr, XN, ssq, p.in[10] + l * 1024, sl1, c1}; pg8::gemm_phase<pg8::EpiNorm<true, false>, pg8::StaticOrder, false, true>(lds3, g, S, E); }
            else { pg8::EpiNorm<false, false> E{XN, nullptr, XN, ssq, p.in[10] + l * 1024, sl1, c1}; pg8::gemm_phase<pg8::EpiNorm<false, false>, pg8::StaticOrder, false, true>(lds3, g, S, E); }
        }
        SEAM(pb + 2);
        if (EN(4) && IN(pb + 3)) {
            const bf16_t* Wt = (const bf16_t*)(p.ws + WS_WUP) + (size_t)l * 4194304; bf16_t* HB = (bf16_t*)(p.ws + WS_HB);
            for (int reps = 0; reps < PROBE_SK; ++reps)
            for (int u = bx; u < 128; u += G) {
                f32x4 o[2];
                skinny_gemm(XN + (size_t)MP * DM, Wt, 1024, 0, u * 32, ldsf, o);
                const int w = tid >> 6, r32 = lane & 31, h = lane >> 5; const int row = 32 * (w >> 1) + r32; const float rsr = sample_rs(ssq_s, row);
#pragma unroll
                for (int g = 0; g < 2; ++g) { const int col = u * 32 + 16 * (w & 1) + 8 * g + 4 * h; f32x4 v = o[g];
#pragma unroll
                    for (int e = 0; e < 4; ++e) { const float a = (v[e] > 0.f ? v[e] : 0.f) * rsr; v[e] = a * a; }
                    u32x2 wv; wv.x = pk2(v.x, v.y); wv.y = pk2(v.z, v.w); *(u32x2*)(HB + (size_t)MP * FF + foff(row, col, FF)) = wv; }
            }
            __syncthreads();
            pg8::Gemm g{XN, Wt, MP, FF, 1024};
            pg8::StaticOrder S; S.init(MP, FF, G, bx);
            { pg8::Unit u0; if (S.next(0, u0)) panel_rs(ssq, u0.pm, rsL); else __syncthreads(); }
            pg8::EpiUp E{HB, FF, rsL3};
#ifndef PROBE_UP
#define PROBE_UP 1
#endif
            pg8::gemm_phase<pg8::EpiUp, pg8::StaticOrder, true, true>(lds3, g, S, E);
            if (PROBE_UP > 1 && l == 0) { __syncthreads(); pg8::gemm_phase<pg8::EpiUp, pg8::StaticOrder, true, true>(lds3, g, S, E); }
        }
        SEAM(pb + 3);
        if (EN(5) && IN(pb + 4)) {
            const int bk = 2 * l + 1;
            float* sl1 = slots + (size_t)bk * SLOT_BANK; unsigned* c1 = ctl + CW_CNT + bk * 80 * 64;
            const bf16_t* Wt = (const bf16_t*)(p.ws + WS_WDN) + (size_t)l * 4194304; const bf16_t* HB = (const bf16_t*)(p.ws + WS_HB);
            for (int u = bx; u < 32; u += G) {
                f32x4 o[2];
                skinny_gemm(HB + (size_t)MP * FF, Wt, FF, 0, u * 32, ldsf, o);
                skinny_norm(o, u, X + (size_t)MP * DM, X + (size_t)MP * DM, l == 0 ? XN + (size_t)MP * DM : nullptr, ssq_s, p.in[12] + l * 1024, sl1 + 65536, c1 + 64 * 64, ldsf);
            }
            __syncthreads();
            int Kd = FF; asm volatile("" : "+s"(Kd));
            pg8::Gemm g{HB, Wt, MP, 1024, Kd};
            pg8::StaticOrder S; S.init(MP, 1024, G, bx);
            if (l == 0) { pg8::EpiNorm<false, false> E{XN, nullptr, XN, ssq, p.in[12] + l * 1024, sl1, c1}; pg8::gemm_phase<pg8::EpiNorm<false, false>, pg8::StaticOrder, false, true>(lds3, g, S, E); }
            else { pg8::EpiNorm<false, true> E{XN, X, nullptr, nullptr, p.in[12] + l * 1024, sl1, c1}; pg8::gemm_phase<pg8::EpiNorm<false, true>, pg8::StaticOrder, false, true>(lds3, g, S, E); }
        }
        if (l == 0) SEAM(pb + 4);

}
__global__ void __launch_bounds__(NTHR, 2) yoco_fwd(Params p) {
    unsigned char* lds = lds_raw_;
    cg::grid_group grid = cg::this_grid();
    { const unsigned key = (unsigned)__builtin_amdgcn_s_getreg((5 << 11) | 4) & 63u; if ((threadIdx.x & 63) == 0) ((volatile int*)(lds_raw_ + TIDX_LDS_OFF))[key] = (int)(threadIdx.x >> 6); }
    __syncthreads();
    const int tid = tidx(), lane = tid & 63, wave = __builtin_amdgcn_readfirstlane(tid >> 6);
    const int G = gridDim.x, bx = blockIdx.x;
    unsigned* ctl = (unsigned*)(p.ws + WS_CTL);
    float* slots = (float*)(p.ws + WS_SLOTS);
    int* qslot = (int*)(lds + MISC_OFF);
    float* ldsf = (float*)lds;
    PG8_LAS unsigned char* lds3 = (PG8_LAS unsigned char*)lds;
    bf16_t* XN = (bf16_t*)(p.ws + WS_XN);
    float* X = p.out + O_Y;
    const int lo = p.ph_lo, hi = p.ph_hi;
    if (tid < 32) ((volatile unsigned*)(lds + MISC_OFF))[tid] = 0u;
    __syncthreads();
    XcdBarrier bar = xcd_barrier_post(ctl + CW_BAR, (volatile LAS unsigned*)(lds + MISC_OFF) + 8);

#ifndef PROBE_P0
#define PROBE_P0 1
#endif
    if (EN(0) && IN(0)) for (int rep0 = 0; rep0 < PROBE_P0; ++rep0) {
        float* scr = (float*)(lds + wave * 16640);
        const int gw = bx * 8 + wave, NGW = G * 8;
        constexpr int I_SQ = 16 * 16, I_PL = 2 * 2;
        constexpr int NITEMS = 3 * I_SQ + 4 * I_PL;
        for (int it = gw; it < NITEMS; it += NGW) {
            int r = it;
            if (r < I_SQ) { transpose_item(p.in[13], 1024, 1024, 1024, p.in[9], (bf16_t*)(p.ws + WS_WIN0), scr, r, lane); continue; } r -= I_SQ;
            if (r < I_SQ) { transpose_item(p.in[21], 1024, 1024, 1024, p.in[20], (bf16_t*)(p.ws + WS_WMEM), scr, r, lane); continue; } r -= I_SQ;
            if (r < I_SQ) { transpose_item(p.in[21] + 1048576, 1024, 1024, 1024, p.in[20] + 1024, (bf16_t*)(p.ws + WS_WMEM) + 1048576, scr, r, lane); continue; } r -= I_SQ;
            { const int gq = r / I_PL; transpose_item(p.in[15] + gq * 16384, 128, 128, 128, nullptr, (bf16_t*)(p.ws + WS_WPOOL) + gq * 16384, scr, r % I_PL, lane); }
        }
        for (int m = gw; m < MT + 1024; m += NGW) {
            if (m < MP) norm_row_to_bf16(p.in[0] + (size_t)m * DM, XN + (size_t)m * DM, lane);
            else if (m < MT) norm_row_to_bf16(p.in[1] + (size_t)(m - MP) * DM, XN + (size_t)MP * DM, lane, m - MP);
            else norm_row_to_bf16(p.in[8] + (size_t)(m - MT) * DM, (bf16_t*)(p.ws + WS_MN), lane, m - MT);
        }
        const size_t gtid = (size_t)bx * NTHR + tid, gn = (size_t)G * NTHR;
        cvt_rows(p.in[6], (bf16_t*)(p.ws + WS_MKS), (size_t)2 * DB * NMEM * 512 / 8, 64, 1, 1, gtid, gn);
        cvt_rows(p.in[7], (bf16_t*)(p.ws + WS_MVS), (size_t)2 * DB * NMEM * 512 / 8, 64, 1, 1, gtid, gn);
        for (size_t i = gtid; i < 32 * 1024; i += gn) { const int rr = (int)(i >> 10), k = (int)(i & 1023); const float v = rr < 8 ? p.in[17][k] * p.in[18][(size_t)k * 1032 + 1024 + rr] : 0.f; ((bf16_t*)(p.ws + WS_WF))[i] = f2bf(v); }
        __syncthreads();
    }
    SEAM(0);

    layer_phases<0>(p, lds, bar, lo, hi);
    layer_phases<1>(p, lds, bar, lo, hi);
    if (hi > 1000) grid.sync();
#undef IN
#undef SEAM
}

#ifndef MK_N_LAUNCHES
#define MK_N_LAUNCHES 1
#endif
extern "C" void kernel_launch(void* const* d_in, const int* in_sizes, int n_in, void* d_out, int out_size, void* d_ws, size_t ws_size, hipStream_t stream) {
    static int grid = 0;
    if (grid == 0) {
        if (n_in != 24 || ws_size < WS_END) { fprintf(stderr, "kernel_launch: unexpected problem (n_in %d, ws %zu)\n", n_in, ws_size); grid = -1; return; }
        int dev = 0, cus = 0, per_cu = 0;
        if (hipGetDevice(&dev) != hipSuccess || hipDeviceGetAttribute(&cus, hipDeviceAttributeMultiprocessorCount, dev) != hipSuccess) { grid = -1; return; }
        if (hipFuncSetAttribute((const void*)yoco_fwd, hipFuncAttributeMaxDynamicSharedMemorySize, LDS_BYTES) != hipSuccess) { fprintf(stderr, "kernel_launch: hipFuncSetAttribute failed\n"); grid = -1; return; }
        if (hipOccupancyMaxActiveBlocksPerMultiprocessor(&per_cu, (const void*)yoco_fwd, NTHR, LDS_BYTES) != hipSuccess || per_cu < 1) { fprintf(stderr, "kernel_launch: occupancy query says %d\n", per_cu); per_cu = 1; }
        (void)hipGetLastError();
        grid = cus;
        if (grid != 256) fprintf(stderr, "kernel_launch: %d CUs; this kernel is built for 256\n", grid);
    }
    if (grid < 0) return;
    (void)hipMemsetAsync((char*)d_ws + WS_CTL, 0, CTL_BYTES, stream);
    Params a{};
    for (int i = 0; i < 24; ++i) a.in[i] = (const float*)d_in[i];
    a.out = (float*)d_out; a.ws = (unsigned char*)d_ws;
    constexpr int NPH = 11;
    if (MK_N_LAUNCHES == 1) {
        a.ph_lo = 0; a.ph_hi = NPH;
        void* args[] = {&a};
        hipError_t e = hipLaunchCooperativeKernel((const void*)yoco_fwd, dim3(grid), dim3(NTHR), args, LDS_BYTES, stream);
        if (e != hipSuccess) fprintf(stderr, "cooperative launch failed: %s (grid %d)\n", hipGetErrorString(e), grid);
    } else {
        for (int ph = 0; ph < NPH; ++ph) {
            a.ph_lo = ph; a.ph_hi = ph + 1;
            void* args[] = {&a};
            hipError_t e = hipLaunchCooperativeKernel((const void*)yoco_fwd, dim3(grid), dim3(NTHR), args, LDS_BYTES, stream);
            if (e != hipSuccess) { fprintf(stderr, "cooperative launch %d failed: %s (grid %d)\n", ph, hipGetErrorString(e), grid); break; }
        }
    }
}
```

```cpp
#include <hip/hip_runtime.h>
#include <hip/hip_cooperative_groups.h>
#include <cstdio>
#include <cstdint>
namespace cg = cooperative_groups;

#define TIDX_LDS_OFF 146944
extern __shared__ __attribute__((aligned(16))) unsigned char lds_raw_[];
__device__ __forceinline__ int tidx() {
    const unsigned key = (unsigned)__builtin_amdgcn_s_getreg((5 << 11) | 4) & 63u;
    const int wv = __builtin_amdgcn_readfirstlane(((volatile const int*)(lds_raw_ + TIDX_LDS_OFF))[key]);
    return wv * 64 + (int)__builtin_amdgcn_mbcnt_hi(~0u, __builtin_amdgcn_mbcnt_lo(~0u, 0u));
}
namespace pg8 {
#define PG8_LAS __attribute__((address_space(3)))
typedef unsigned short bf16_t;
typedef short bf16x8 __attribute__((ext_vector_type(8)));
typedef float f32x4 __attribute__((ext_vector_type(4)));
typedef unsigned u32x4 __attribute__((ext_vector_type(4)));
constexpr int BM = 256, BK = 64, HALF = 128, HTB = HALF * BK * 2  , STAGE_BYTES = 8 * HTB, NXCD = 8, WGM = 8;

__host__ __device__ __forceinline__ int lds_byte(int r, int c) { const int st = (r >> 4) * 2 + (c >> 5), rr = r & 15, cc = c & 31, ob = rr * 64 + cc * 2; return st * 1024 + (ob ^ (((ob >> 9) & 1) << 5)); }
__host__ __device__ __forceinline__ void stage_rc(int b, int& R, int& C) { const int st = b / 1024, sb = b % 1024, swz = sb ^ (((sb >> 9) & 1) << 5); R = (st >> 1) * 16 + swz / 64; C = (st & 1) * 32 + (swz % 64) / 2; }
__host__ __device__ __forceinline__ int perm32(int rho) { const int n = rho >> 4, i = rho & 15; return 8 * (i >> 2) + 4 * n + (i & 3); }

struct Unit { int pm, pn; };
struct Gemm { const bf16_t* A; const bf16_t* Bt; int M, N, K; };

struct StaticOrder {
    int nM, nN, nwg, G, c;
    __host__ __device__ void init(int M, int N, int G_, int c_) { nM = M / BM; nN = N / BM; nwg = nM * nN; G = G_; c = c_; }
    __host__ __device__ bool next(int i, Unit& u) const {
        const long L = (long)i * G + c; if (L >= nwg) return false;
        int wgid = (int)L; { const int q = nwg / NXCD, r = nwg % NXCD, xcd = wgid % NXCD, off = wgid / NXCD; wgid = (xcd < r ? xcd * (q + 1) : r * (q + 1) + (xcd - r) * q) + off; }
        const int nig = WGM * nN, gid = wgid / nig, fm = gid * WGM, gsz = (nM - fm) < WGM ? (nM - fm) : WGM;
        u.pm = fm + ((wgid % nig) % gsz); u.pn = (wgid % nig) / gsz; return true;
    }
    __device__ __forceinline__ void a_ready(const Unit&) const {}
    __device__ __forceinline__ void done(const Unit&) const {}
};


typedef float f32x2_t __attribute__((ext_vector_type(2))); typedef __bf16 bf16x2_t __attribute__((ext_vector_type(2)));
typedef unsigned u32x2 __attribute__((ext_vector_type(2)));
__device__ __forceinline__ unsigned cvt_pk_bf16(float lo, float hi) { unsigned r; asm volatile("v_cvt_pk_bf16_f32 %0, %1, %2" : "=v"(r) : "v"(lo), "v"(hi)); return r; }
__device__ __forceinline__ unsigned pk2(float lo, float hi) { f32x2_t v = {lo, hi}; bf16x2_t b = __builtin_convertvector(v, bf16x2_t); return __builtin_bit_cast(unsigned, b); }

struct EpiProj {
    static constexpr bool PERM = true, AFTER_DRAIN = false;
    bf16_t* MI; bf16_t* MQ; bf16_t* KB; bf16_t* VB; float* kout; float* vout; float smi, smq; const PG8_LAS float* rs;
    __device__ __forceinline__ void operator()(const f32x4 (&acc)[2][2][4][2], const Unit& u, int wr, int wc, int fr, int fq) const {
        const int row0 = u.pm * BM + wr * 64 + fr; const int sec = u.pn >> 1; const int colt = (u.pn & 1) * 256 + wc * 32 + 8 * fq;
        bf16_t* bdst = sec == 0 ? MI : sec == 1 ? MQ : sec == 2 ? KB : VB; float* fdst = sec == 2 ? kout : sec == 3 ? vout : nullptr; const float sc = sec == 0 ? smi : sec == 1 ? smq : 1.f;
#pragma unroll
        for (int ai = 0; ai < 2; ++ai)
#pragma unroll
            for (int m = 0; m < 4; ++m) { const size_t ro = (size_t)(row0 + ai * HALF + m * 16) * 512 + colt; const float scr = rs ? sc * rs[ai * HALF + wr * 64 + m * 16 + fr] : sc;
#pragma unroll
                for (int bj = 0; bj < 2; ++bj) { const f32x4 v0 = acc[ai][bj][m][0] * scr, v1 = acc[ai][bj][m][1] * scr;
                    u32x4 w; w.x = cvt_pk_bf16(v0[0], v0[1]); w.y = cvt_pk_bf16(v0[2], v0[3]); w.z = cvt_pk_bf16(v1[0], v1[1]); w.w = cvt_pk_bf16(v1[2], v1[3]);
                    *(u32x4*)(bdst + ro + bj * HALF) = w;
                    if (fdst) { __builtin_nontemporal_store(v0, (f32x4*)(fdst + ro + bj * HALF)); __builtin_nontemporal_store(v1, (f32x4*)(fdst + ro + bj * HALF + 4)); } } }
    }
};
struct EpiUp {
    static constexpr bool PERM = true, AFTER_DRAIN = false;
    bf16_t* O; int ldc; const PG8_LAS float* rs;
    __device__ __forceinline__ void operator()(const f32x4 (&acc)[2][2][4][2], const Unit& u, int wr, int wc, int fr, int fq) const {
        const int row0 = u.pm * BM + wr * 64 + fr; const int col0 = u.pn * BM + wc * 32 + 8 * fq;
#pragma unroll
        for (int ai = 0; ai < 2; ++ai)
#pragma unroll
            for (int m = 0; m < 4; ++m) { bf16_t* rowp = O + (size_t)(row0 + ai * HALF + m * 16) * ldc + col0; const float rr = rs[ai * HALF + wr * 64 + m * 16 + fr];
#pragma unroll
                for (int bj = 0; bj < 2; ++bj) { f32x4 v0 = acc[ai][bj][m][0], v1 = acc[ai][bj][m][1];
#pragma unroll
                    for (int i = 0; i < 4; ++i) { const float a = (v0[i] > 0.f ? v0[i] : 0.f) * rr, b = (v1[i] > 0.f ? v1[i] : 0.f) * rr; v0[i] = a * a; v1[i] = b * b; }
                    u32x4 w; w.x = cvt_pk_bf16(v0[0], v0[1]); w.y = cvt_pk_bf16(v0[2], v0[3]); w.z = cvt_pk_bf16(v1[0], v1[1]); w.w = cvt_pk_bf16(v1[2], v1[3]);
                    *(u32x4*)(rowp + bj * HALF) = w; } }
    }
};
template <bool BASE_F32, bool FINAL>
struct EpiNorm {
    static constexpr bool PERM = true, AFTER_DRAIN = true;
    const void* base; float* out; bf16_t* xb; float* ssq; const float* gain; float* slots1; unsigned* cnt1;
    __device__ __forceinline__ void stats(const f32x4 (&v)[2][2][4][2], const Unit& u, int wr, int wc, int fr, int fq, PG8_LAS unsigned char* lds, int wid, int lane, float* slots, unsigned* cnt) const {
        PG8_LAS float* P = (PG8_LAS float*)lds;
        PG8_LAS float* S = (PG8_LAS float*)(lds + 4096);
#pragma unroll
        for (int ai = 0; ai < 2; ++ai)
#pragma unroll
            for (int m = 0; m < 4; ++m) {
                float s = 0.f;
#pragma unroll
                for (int bj = 0; bj < 2; ++bj)
#pragma unroll
                    for (int n = 0; n < 2; ++n) { const f32x4 x = v[ai][bj][m][n]; s += (x[0] * x[0] + x[1] * x[1]) + (x[2] * x[2] + x[3] * x[3]); }
                s += __shfl_xor(s, 16); s += __shfl_xor(s, 32);
                if (fq == 0) P[(ai * HALF + wr * 64 + m * 16 + fr) * 4 + wc] = s;
            }
        asm volatile("s_waitcnt lgkmcnt(0)" ::: "memory"); __builtin_amdgcn_s_barrier(); asm volatile("" ::: "memory");
        const int row = wid * 32 + (lane & 31);
        if (lane < 32) {
            const float s = (P[row * 4 + 0] + P[row * 4 + 1]) + (P[row * 4 + 2] + P[row * 4 + 3]);
            __hip_atomic_store(slots + ((size_t)(u.pm * BM + row) * 4 + u.pn), s, __ATOMIC_RELAXED, __HIP_MEMORY_SCOPE_AGENT);
        }
        asm volatile("s_waitcnt vmcnt(0)" ::: "memory");
        if (lane == 0) __hip_atomic_fetch_add(cnt + 64 * u.pm, 1u, __ATOMIC_RELAXED, __HIP_MEMORY_SCOPE_AGENT);
        if (wid == 0) {
            unsigned spins = 0;
            for (;;) {
                if ((unsigned)__builtin_amdgcn_readfirstlane(__hip_atomic_load(cnt + 64 * u.pm, __ATOMIC_RELAXED, __HIP_MEMORY_SCOPE_AGENT)) >= 32u) break;
                if (++spins > (1u << 22)) break;
                __builtin_amdgcn_s_sleep(2);
            }
            __builtin_amdgcn_fence(__ATOMIC_ACQUIRE, "agent");
        }
        asm volatile("s_waitcnt vmcnt(0) lgkmcnt(0)" ::: "memory"); __builtin_amdgcn_s_barrier(); asm volatile("" ::: "memory");
        if (lane < 32) {
            const float* sl = slots + (size_t)(u.pm * BM + row) * 4; float t = 0.f;
#pragma unroll
            for (int q = 0; q < 4; ++q) t += __hip_atomic_load(sl + q, __ATOMIC_RELAXED, __HIP_MEMORY_SCOPE_AGENT);
            S[row] = 1.0f / sqrtf(t * (1.0f / 1024.0f) + 1e-6f);
        }
        asm volatile("s_waitcnt vmcnt(0) lgkmcnt(0)" ::: "memory"); __builtin_amdgcn_s_barrier(); asm volatile("" ::: "memory");
    }
    __device__ __forceinline__ void fused(f32x4 (&acc)[2][2][4][2], const Unit& u, int wr, int wc, int fr, int fq, PG8_LAS unsigned char* lds, int wid, int lane) const {
        const PG8_LAS float* S = (const PG8_LAS float*)(lds + 4096);
        const int col0 = u.pn * BM + wc * 32 + 8 * fq;
        stats(acc, u, wr, wc, fr, fq, lds, wid, lane, slots1, cnt1);
        f32x4 gv[2][2];
#pragma unroll
        for (int bj = 0; bj < 2; ++bj)
#pragma unroll
            for (int n = 0; n < 2; ++n) gv[bj][n] = *(const f32x4*)(gain + col0 + bj * HALF + n * 4);
#pragma unroll
        for (int ai = 0; ai < 2; ++ai)
#pragma unroll
            for (int m = 0; m < 4; ++m) { const int r = ai * HALF + wr * 64 + m * 16 + fr; const float rs = S[r]; const size_t off = (size_t)(u.pm * BM + r) * 1024 + col0;
                float sq = 0.f;
#pragma unroll
                for (int bj = 0; bj < 2; ++bj) { f32x4 b0, b1;
                    if (BASE_F32) { b0 = __builtin_nontemporal_load((const f32x4*)((const float*)base + off + bj * HALF)); b1 = __builtin_nontemporal_load((const f32x4*)((const float*)base + off + bj * HALF + 4)); }
                    else { const u32x4 bw = __builtin_nontemporal_load((const u32x4*)((const bf16_t*)base + off + bj * HALF));
                        b0 = (f32x4){__uint_as_float(bw.x << 16), __uint_as_float(bw.x & 0xffff0000u), __uint_as_float(bw.y << 16), __uint_as_float(bw.y & 0xffff0000u)};
                        b1 = (f32x4){__uint_as_float(bw.z << 16), __uint_as_float(bw.z & 0xffff0000u), __uint_as_float(bw.w << 16), __uint_as_float(bw.w & 0xffff0000u)}; }
                    const f32x4 x0 = b0 + acc[ai][bj][m][0] * gv[bj][0] * rs, x1 = b1 + acc[ai][bj][m][1] * gv[bj][1] * rs;
                    if (FINAL) { __builtin_nontemporal_store(x0, (f32x4*)(out + off + bj * HALF)); __builtin_nontemporal_store(x1, (f32x4*)(out + off + bj * HALF + 4)); }
                    else { sq += ((x0[0] * x0[0] + x0[1] * x0[1]) + (x0[2] * x0[2] + x0[3] * x0[3])) + ((x1[0] * x1[0] + x1[1] * x1[1]) + (x1[2] * x1[2] + x1[3] * x1[3]));
                        u32x4 w; w.x = cvt_pk_bf16(x0[0], x0[1]); w.y = cvt_pk_bf16(x0[2], x0[3]); w.z = cvt_pk_bf16(x1[0], x1[1]); w.w = cvt_pk_bf16(x1[2], x1[3]); *(u32x4*)(xb + off + bj * HALF) = w; } }
                if (!FINAL) { sq += __shfl_xor(sq, 16); sq += __shfl_xor(sq, 32); if (fq == 0) ssq[(size_t)(u.pm * BM + r) * 16 + u.pn * 4 + wc] = sq; }
                if (m & 1) asm volatile("" ::: "memory"); }
    }
};

template <class Epi, class Sched, bool ALIGN_EPI = false, bool SP2 = false>
__device__ __forceinline__ void gemm_phase(PG8_LAS unsigned char* lds, const Gemm g, const Sched& S, const Epi& E) {
    const int tid = tidx(), wid = __builtin_amdgcn_readfirstlane(tid >> 6), lane = tid & 63, wr = wid >> 2, wc = wid & 3, fr = lane & 15, fq = lane >> 4;
    const int K = g.K, nt = K / BK;
    unsigned voffA[2], voffB[2];
#pragma unroll
    for (int i = 0; i < 2; ++i) { int R, C; stage_rc(tid * 16 + i * 8192, R, C); const int Rb = Epi::PERM ? ((R & ~31) + perm32(R & 31)) : R;
        voffA[i] = (unsigned)(R * K + C) * 2u; voffB[i] = (unsigned)(Rb * K + C) * 2u; }
    const size_t kstep = (size_t)(BK * 2);
    const size_t hstep = (size_t)HALF * K * 2;
    const size_t tstep = 2 * hstep;
    const unsigned ldsw = (unsigned)wid * 1024u;
    const int aoff = lds_byte(wr * 64 + fr, fq * 8), boff = lds_byte(wc * 32 + fr, fq * 8);
#define PG8_SA(b, h) (((b) * 2 + (h)) * HTB)
#define PG8_SB(b, h) ((4 + (b) * 2 + (h)) * HTB)
#define PG8_STAGE(bufoff, gbase, voff) do { _Pragma("unroll") for (int _i = 0; _i < 2; ++_i) \
        __builtin_amdgcn_global_load_lds((const unsigned*)((const char*)(gbase) + (voff)[_i]), (PG8_LAS unsigned*)(lds + (bufoff) + ldsw + _i * 8192), 16, 0, 0); } while (0)
#define PG8_LDA(dst, b, h) do { _Pragma("unroll") for (int m = 0; m < 4; ++m) _Pragma("unroll") for (int k = 0; k < 2; ++k) dst[m][k] = *(const PG8_LAS bf16x8*)(lds + PG8_SA(b, h) + aoff + m * 2048 + k * 1024); } while (0)
#define PG8_LDB(dst, b, h) do { _Pragma("unroll") for (int n = 0; n < 2; ++n) _Pragma("unroll") for (int k = 0; k < 2; ++k) dst[n][k] = *(const PG8_LAS bf16x8*)(lds + PG8_SB(b, h) + boff + n * 2048 + k * 1024); } while (0)
#define PG8_MMA(ai, bj, At, Bt) do { __builtin_amdgcn_s_setprio(1); _Pragma("unroll") for (int m = 0; m < 4; ++m) _Pragma("unroll") for (int n = 0; n < 2; ++n) _Pragma("unroll") for (int k = 0; k < 2; ++k) \
        acc[ai][bj][m][n] = __builtin_amdgcn_mfma_f32_16x16x32_bf16(Bt[n][k], At[m][k], acc[ai][bj][m][n], 0, 0, 0); __builtin_amdgcn_s_setprio(0); } while (0)
#define PG8_WAIT_V(n) asm volatile("s_waitcnt vmcnt(" #n ")" ::: "memory")
#define PG8_WAIT_L(n) asm volatile("s_waitcnt lgkmcnt(" #n ")" ::: "memory")
#define PG8_BAR __builtin_amdgcn_s_barrier()
#define PG8_SCHED __builtin_amdgcn_sched_barrier(0)
    Unit cur, nxt; int ui = 0;
    if (!S.next(0, cur)) return;
    f32x4 acc[2][2][4][2];
#pragma unroll
    for (int a = 0; a < 2; ++a)
#pragma unroll
        for (int b = 0; b < 2; ++b)
#pragma unroll
            for (int m = 0; m < 4; ++m)
#pragma unroll
                for (int n = 0; n < 2; ++n) acc[a][b][m][n] = (f32x4){0.f, 0.f, 0.f, 0.f};
    bf16x8 At[4][2], B0[2][2], B1[2][2];
    const char* cA = (const char*)g.A + (size_t)cur.pm * tstep; const char* cB = (const char*)g.Bt + (size_t)cur.pn * tstep;
    S.a_ready(cur);
    if constexpr (SP2) {
        PG8_STAGE(PG8_SB(0, 0), cB, voffB); PG8_STAGE(PG8_SB(0, 1), cB + hstep, voffB); PG8_STAGE(PG8_SA(0, 0), cA, voffA); PG8_STAGE(PG8_SA(0, 1), cA + hstep, voffA);
        if (wr == 1) PG8_BAR;
        PG8_WAIT_V(2); PG8_BAR;
        PG8_STAGE(PG8_SB(1, 0), cB + kstep, voffB); PG8_STAGE(PG8_SA(1, 0), cA + kstep, voffA); PG8_STAGE(PG8_SB(1, 1), cB + hstep + kstep, voffB);
        PG8_WAIT_V(6); PG8_BAR;
    } else {
        PG8_STAGE(PG8_SB(0, 0), cB, voffB); PG8_STAGE(PG8_SA(0, 0), cA, voffA); PG8_STAGE(PG8_SB(0, 1), cB + hstep, voffB); PG8_STAGE(PG8_SA(0, 1), cA + hstep, voffA);
        if (wr == 1) PG8_BAR;
        PG8_WAIT_V(4); PG8_BAR;
        PG8_STAGE(PG8_SB(1, 0), cB + kstep, voffB); PG8_STAGE(PG8_SA(1, 0), cA + kstep, voffA); PG8_STAGE(PG8_SB(1, 1), cB + hstep + kstep, voffB);
        PG8_WAIT_V(6); PG8_BAR;
    }
    for (;;) {
        const bool has_next = S.next(ui + 1, nxt);
        const char* nA = has_next ? (const char*)g.A + (size_t)nxt.pm * tstep : cA; const char* nB = has_next ? (const char*)g.Bt + (size_t)nxt.pn * tstep : cB;
        for (int t = 0; t < nt; t += 2) {
            const bool last = (t == nt - 2);
            const char* a1 = cA + (size_t)(t + 1) * kstep;
            const char* a2 = last ? nA : cA + (size_t)(t + 2) * kstep; const char* b2 = last ? nB : cB + (size_t)(t + 2) * kstep;
            const char* a3 = a2 + kstep; const char* b3 = b2 + kstep;
            if (last && has_next) S.a_ready(nxt);
            if constexpr (SP2) {
            PG8_LDB(B0, 0, 0); PG8_LDB(B1, 0, 1); PG8_SCHED; PG8_LDA(At, 0, 0); PG8_STAGE(PG8_SA(1, 1), a1 + hstep, voffA);
            PG8_WAIT_V(8); PG8_WAIT_L(0); PG8_BAR; PG8_MMA(0, 0, At, B0); PG8_MMA(0, 1, At, B1); PG8_BAR; PG8_SCHED;
            PG8_LDA(At, 0, 1); PG8_STAGE(PG8_SB(0, 0), b2, voffB); PG8_STAGE(PG8_SB(0, 1), b2 + hstep, voffB); PG8_STAGE(PG8_SA(0, 0), a2, voffA);
            PG8_WAIT_V(8); PG8_WAIT_L(0); PG8_BAR; PG8_MMA(1, 0, At, B0); PG8_MMA(1, 1, At, B1); PG8_BAR; PG8_SCHED;
            PG8_LDB(B0, 1, 0); PG8_LDB(B1, 1, 1); PG8_SCHED; PG8_LDA(At, 1, 0); PG8_STAGE(PG8_SA(0, 1), a2 + hstep, voffA);
            PG8_WAIT_V(8); PG8_WAIT_L(0); PG8_BAR; PG8_MMA(0, 0, At, B0); PG8_MMA(0, 1, At, B1); PG8_BAR; PG8_SCHED;
            PG8_LDA(At, 1, 1); PG8_STAGE(PG8_SB(1, 0), b3, voffB); PG8_STAGE(PG8_SB(1, 1), b3 + hstep, voffB); PG8_STAGE(PG8_SA(1, 0), a3, voffA);
            PG8_WAIT_V(8); PG8_WAIT_L(0); PG8_BAR; PG8_MMA(1, 0, At, B0); PG8_MMA(1, 1, At, B1); PG8_BAR; PG8_SCHED;
            } else {
            PG8_LDB(B0, 0, 0); PG8_SCHED; PG8_LDA(At, 0, 0); PG8_STAGE(PG8_SA(1, 1), a1 + hstep, voffA);
            PG8_WAIT_L(8); PG8_BAR; PG8_WAIT_L(0); PG8_MMA(0, 0, At, B0); PG8_BAR; PG8_SCHED;
            PG8_LDB(B1, 0, 1); PG8_STAGE(PG8_SB(0, 0), b2, voffB);
            PG8_BAR; PG8_WAIT_L(0); PG8_MMA(0, 1, At, B1); PG8_BAR;
            PG8_LDA(At, 0, 1); PG8_STAGE(PG8_SA(0, 0), a2, voffA);
            PG8_BAR; PG8_WAIT_L(0); PG8_MMA(1, 0, At, B0); PG8_BAR; PG8_SCHED;
            PG8_STAGE(PG8_SB(0, 1), b2 + hstep, voffB);
            PG8_WAIT_V(6); PG8_BAR; PG8_MMA(1, 1, At, B1); PG8_BAR;
            PG8_LDB(B0, 1, 0); PG8_SCHED; PG8_LDA(At, 1, 0); PG8_STAGE(PG8_SA(0, 1), a2 + hstep, voffA);
            PG8_WAIT_L(8); PG8_BAR; PG8_WAIT_L(0); PG8_MMA(0, 0, At, B0); PG8_BAR; PG8_SCHED;
            PG8_LDB(B1, 1, 1); PG8_STAGE(PG8_SB(1, 0), b3, voffB);
            PG8_BAR; PG8_WAIT_L(0); PG8_MMA(0, 1, At, B1); PG8_BAR;
            PG8_LDA(At, 1, 1); PG8_STAGE(PG8_SA(1, 0), a3, voffA);
            PG8_BAR; PG8_WAIT_L(0); PG8_MMA(1, 0, At, B0); PG8_BAR; PG8_SCHED;
            PG8_STAGE(PG8_SB(1, 1), b3 + hstep, voffB);
            PG8_WAIT_V(6); PG8_BAR; PG8_MMA(1, 1, At, B1); PG8_BAR;
            }
        }
        if constexpr (ALIGN_EPI) { if (wr == 0) PG8_BAR; }
        if constexpr (!Epi::AFTER_DRAIN) { E(acc, cur, wr, wc, fr, fq); S.done(cur); }
        if (!has_next) break;
#pragma unroll
        for (int a = 0; a < 2; ++a)
#pragma unroll
            for (int b = 0; b < 2; ++b)
#pragma unroll
                for (int m = 0; m < 4; ++m)
#pragma unroll
                    for (int n = 0; n < 2; ++n) acc[a][b][m][n] = (f32x4){0.f, 0.f, 0.f, 0.f};
        cur = nxt; cA = nA; cB = nB; ++ui;
        if constexpr (ALIGN_EPI) { if (wr == 1) PG8_BAR; }
    }
    PG8_WAIT_V(0);
    if constexpr (!ALIGN_EPI) { if (wr == 0) PG8_BAR; }
    PG8_BAR;
    if constexpr (Epi::AFTER_DRAIN) { E.fused(acc, cur, wr, wc, fr, fq, lds, wid, lane); S.done(cur); }
#undef PG8_SA
#undef PG8_SB
#undef PG8_STAGE
#undef PG8_LDA
#undef PG8_LDB
#undef PG8_MMA
#undef PG8_WAIT_V
#undef PG8_WAIT_L
#undef PG8_BAR
#undef PG8_SCHED
}
}

using pg8::bf16_t; using pg8::bf16x8; using pg8::f32x4; using pg8::u32x4; using pg8::u32x2; using pg8::pk2;
typedef float f32x16 __attribute__((ext_vector_type(16)));
typedef float f32x2v __attribute__((ext_vector_type(2)));
typedef short s16x4v __attribute__((ext_vector_type(4)));
#define LAS3 __attribute__((address_space(3)))
typedef short s16x8 __attribute__((ext_vector_type(8)));
constexpr int DM = 1024, MP = 16384, MS = 128, MT = MP + MS, SEQ = 4096, NB = 4, DB = 8, DS = 16, PAST = 2048, LKS = 2112  , NKS = 64  , FF = 4096, NMEM = 256;
constexpr float LOG2E = 1.4426950408889634f;
constexpr float CFOX = 0.125f * LOG2E, CMEM = 0.08838834764831845f * LOG2E;
constexpr int NTHR = 512;
constexpr int LDS_BYTES = 147456, RING_BYTES = 131072, MISC_OFF = LDS_BYTES - 256;

constexpr size_t O_Y = 0, O_YS = 16777216, O_PSP = 16908288, O_PSS = 16939008, O_KP = 17000448, O_VP = 25389056, O_LFP = 33777664, O_KS = 33908736, O_VS = 33974272, O_LFS = 34039808, O_MK = 34040832, O_MV = 35089408;

constexpr size_t MiB = 1u << 20;
constexpr size_t WS_CTL = 0, CTL_BYTES = 1 * MiB;
constexpr size_t WS_SLOTS = 1 * MiB;
constexpr size_t SLOT_BANK = 69632;
constexpr size_t WS_WIN0 = 4 * MiB;
constexpr size_t WS_WINKV = 6 * MiB;
constexpr size_t WS_WOUT = 10 * MiB;
constexpr size_t WS_WUP = 14 * MiB;
constexpr size_t WS_WDN = 30 * MiB;
constexpr size_t WS_WMEM = 46 * MiB;
constexpr size_t WS_WPOOL = 50 * MiB;
constexpr size_t WS_WF = 50 * MiB + 512 * 1024;
constexpr size_t WS_MN = 51 * MiB;
constexpr size_t WS_MKVP = 53 * MiB;
constexpr size_t WS_MKS = 57 * MiB;
constexpr size_t WS_MVS = 61 * MiB;
constexpr size_t WS_XN = 65 * MiB;
constexpr size_t WS_OV = 100 * MiB;
constexpr size_t WS_HB = WS_OV;
constexpr size_t WS_MI = WS_OV;
constexpr size_t WS_MQ = WS_OV + 17 * MiB;
constexpr size_t WS_CAT = WS_OV + 34 * MiB;
constexpr size_t WS_KB = WS_OV + 67 * MiB;
constexpr size_t WS_VB = WS_OV + 84 * MiB;
constexpr size_t WS_KSB = WS_OV + 101 * MiB;
constexpr size_t WS_VSB = WS_OV + 118 * MiB;
constexpr size_t WS_SSQ = WS_OV + 135 * MiB;
constexpr size_t WS_END = WS_SSQ + 2 * MiB;
static_assert((size_t)MT * FF * 2 <= 135 * MiB, "HB fits");
constexpr int CW_Q = 64;
constexpr int CW_CNT = 1024;
constexpr int CW_BAR = 65536;

struct Params { const float* in[24]; float* out; unsigned char* ws; int ph_lo, ph_hi; };

#define MFMA32(a, b, c) __builtin_amdgcn_mfma_f32_32x32x16_bf16((a), (b), (c), 0, 0, 0)
__device__ __forceinline__ int crow(int r, int h) { return (r & 3) + 8 * (r >> 2) + 4 * h; }
__device__ __forceinline__ float bf2f(unsigned short u) { return __uint_as_float((unsigned)u << 16); }
__device__ __forceinline__ unsigned short f2bf(float f) { return (unsigned short)(pk2(f, 0.f) & 0xffffu); }
__device__ __forceinline__ size_t foff(int row, int k, int K) { return ((((size_t)(row >> 5) * (K >> 4) + (k >> 4)) * 64 + ((k >> 3) & 1) * 32 + (row & 31)) << 3) + (k & 7); }
__device__ __forceinline__ float wave_sum(float v) {
#pragma unroll
    for (int o = 1; o < 64; o <<= 1) v += __shfl_xor(v, o);
    return v;
}

__device__ __forceinline__ void transpose_item(const float* W, int K, int N, int ldw, const float* gain, bf16_t* WT, float* scr, int item, int lane) {
    const int nblk = N / 64, kb = item / nblk, nb = item % nblk, k0 = 64 * kb, n0 = 64 * nb;
    const int lr = lane >> 4, lc = 4 * (lane & 15);
    f32x4 v[16];
#pragma unroll
    for (int i = 0; i < 16; ++i) v[i] = __builtin_nontemporal_load((const f32x4*)(W + (size_t)(k0 + 4 * i + lr) * ldw + n0 + lc));
#pragma unroll
    for (int i = 0; i < 16; ++i) { const int kk = 4 * i + lr; const float gk = gain ? gain[k0 + kk] : 1.f; float* d = scr + kk * 65 + lc; d[0] = v[i].x * gk; d[1] = v[i].y * gk; d[2] = v[i].z * gk; d[3] = v[i].w * gk; }
    asm volatile("s_waitcnt lgkmcnt(0)" ::: "memory");
    const int c = lane & 7;
#pragma unroll
    for (int j = 0; j < 8; ++j) { const int n = (lane >> 3) + 8 * j; const float* s = scr + (8 * c) * 65 + n;
        u32x4 o; o.x = pk2(s[0 * 65], s[1 * 65]); o.y = pk2(s[2 * 65], s[3 * 65]); o.z = pk2(s[4 * 65], s[5 * 65]); o.w = pk2(s[6 * 65], s[7 * 65]);
        *(u32x4*)(WT + (size_t)(n0 + n) * K + k0 + 8 * c) = o; }
    asm volatile("s_waitcnt lgkmcnt(0)" ::: "memory");
}
__device__ __forceinline__ void norm_row_to_bf16(const float* xrow, bf16_t* orow, int lane, int frow = -1) {
    const f32x4* xr = (const f32x4*)xrow + lane;
    f32x4 v[4]; float s = 0.f;
#pragma unroll
    for (int j = 0; j < 4; ++j) { v[j] = __builtin_nontemporal_load(xr + 64 * j); s += (v[j].x * v[j].x + v[j].y * v[j].y) + (v[j].z * v[j].z + v[j].w * v[j].w); }
    const float rs = 1.f / sqrtf(wave_sum(s) * (1.f / 1024.f) + 1e-6f);
    u32x2* o8 = (u32x2*)orow + lane;
#pragma unroll
    for (int j = 0; j < 4; ++j) { u32x2 w; w.x = pk2(v[j].x * rs, v[j].y * rs); w.y = pk2(v[j].z * rs, v[j].w * rs);
        if (frow < 0) o8[64 * j] = w; else *(u32x2*)(orow + foff(frow, 256 * j + 4 * lane, 1024)) = w; }
}
__device__ __forceinline__ void cvt_rows(const float* src, bf16_t* dst, size_t nchunks  , int chunks_per_row, int rpb, int dpb, size_t gtid, size_t gn) {
    for (size_t c = gtid; c < nchunks; c += gn) {
        const size_t r = c / chunks_per_row; const int cc = (int)(c % chunks_per_row);
        const size_t dr = (r / rpb) * dpb + (r % rpb);
        const f32x4 a = __builtin_nontemporal_load((const f32x4*)(src + c * 8)), b = __builtin_nontemporal_load((const f32x4*)(src + c * 8 + 4));
        u32x4 w; w.x = pk2(a.x, a.y); w.y = pk2(a.z, a.w); w.z = pk2(b.x, b.y); w.w = pk2(b.z, b.w);
        *(u32x4*)(dst + (dr * chunks_per_row + cc) * 8) = w;
    }
}

template <bool AFRAG = true>
__device__ __forceinline__ void skinny_gemm(const bf16_t* A, const bf16_t* Bt, int K_, int row0, int col0, float* red, f32x4 (&o)[2]) {
    const int tid = tidx(), w = tid >> 6, lane = tid & 63, r32 = lane & 31, h = lane >> 5, kg = w & 3, rh = w >> 2;
    int K = K_; asm volatile("" : "+s"(K));
    const int nch = K >> 10;
    unsigned char* Bs = (unsigned char*)red;
    const bf16x8* ap = (const bf16x8*)A + ((size_t)((row0 >> 5) + 2 * rh) * (K >> 4) + 16 * kg) * 64 + lane;
    const size_t rbs = (size_t)(K >> 4) * 64;
    const bf16_t* apr = A + (size_t)(row0 + 64 * rh + r32) * K + 256 * kg + 8 * h;
    f32x16 acc[2];
#pragma unroll
    for (int i = 0; i < 2; ++i)
#pragma unroll
        for (int r = 0; r < 16; ++r) acc[i][r] = 0.f;
    u32x4 br[8];
#define SK_BLOAD(ch) do { _Pragma("unroll") for (int i_ = 0; i_ < 8; ++i_) { const int idx_ = tid + NTHR * i_; br[i_] = *(const u32x4*)(Bt + (size_t)(col0 + (idx_ >> 7)) * K + (ch) * 1024 + (idx_ & 127) * 8); } } while (0)
#define SK_ALOAD(dst, ch, hf) do { _Pragma("unroll") for (int ks_ = 0; ks_ < 8; ++ks_) _Pragma("unroll") for (int rb_ = 0; rb_ < 2; ++rb_) \
        dst[ks_][rb_] = AFRAG ? ap[rb_ * rbs + (size_t)((ch) * 64 + (hf) * 8 + ks_) * 64] : *(const bf16x8*)(apr + (size_t)rb_ * 32 * K + (ch) * 1024 + (hf) * 128 + 16 * ks_); } while (0)
#define SK_COMP(src, hf) do { _Pragma("unroll") for (int ks_ = 0; ks_ < 8; ++ks_) { const bf16x8 b_ = *(const bf16x8*)(Bs + r32 * 2064 + (256 * kg + (hf) * 128 + 16 * ks_ + 8 * h) * 2); \
        _Pragma("unroll") for (int rb_ = 0; rb_ < 2; ++rb_) acc[rb_] = MFMA32(b_, src[ks_][rb_], acc[rb_]); } } while (0)
    bf16x8 a0[8][2];
    SK_BLOAD(0);
#pragma nounroll
    for (int ch = 0; ch < nch; ++ch) {
        SK_ALOAD(a0, ch, 0);
        __syncthreads();
#pragma unroll
        for (int i = 0; i < 8; ++i) { const int idx = tid + NTHR * i; *(u32x4*)(Bs + (idx >> 7) * 2064 + (idx & 127) * 16) = br[i]; }
        __syncthreads();
        if (ch + 1 < nch) SK_BLOAD(ch + 1);
        SK_COMP(a0, 0);
        SK_ALOAD(a0, ch, 1);
        SK_COMP(a0, 1);
    }
#undef SK_BLOAD
#undef SK_ALOAD
#undef SK_COMP
    __syncthreads();
#pragma unroll
    for (int rb = 0; rb < 2; ++rb)
#pragma unroll
        for (int r = 0; r < 16; ++r) red[((kg * 4 + 2 * rh + rb) * 16 + r) * 64 + lane] = acc[rb][r];
    __syncthreads();
    const int rbo = w >> 1, rbase = 8 * (w & 1);
    float v[8];
#pragma unroll
    for (int i = 0; i < 8; ++i) { float s = 0.f;
#pragma unroll
        for (int q = 0; q < 4; ++q) s += red[((q * 4 + rbo) * 16 + rbase + i) * 64 + lane];
        v[i] = s; }
    o[0] = (f32x4){v[0], v[1], v[2], v[3]}; o[1] = (f32x4){v[4], v[5], v[6], v[7]};
    __syncthreads();
}
__device__ __forceinline__ void skinny_rowsum(float s, float* tmp  , float* part  ) {
    const int tid = tidx(), w = tid >> 6, lane = tid & 63, r32 = lane & 31, h = lane >> 5;
    s += __shfl_xor(s, 32);
    if (h == 0) tmp[(w & 1) * 128 + 32 * (w >> 1) + r32] = s;
    __syncthreads();
    if (tid < 128) part[tid] = tmp[tid] + tmp[128 + tid];
    __syncthreads();
}
__device__ __forceinline__ void row_exchange(float* slots  , unsigned* cnt, int nparts, int part, int rows, const float* partL, float* totL) {
    const int tid = tidx(), lane = tid & 63, wid = tid >> 6;
    if (tid < rows) __hip_atomic_store(slots + (size_t)tid * nparts + part, partL[tid], __ATOMIC_RELAXED, __HIP_MEMORY_SCOPE_AGENT);
    asm volatile("s_waitcnt vmcnt(0)" ::: "memory");
    if (lane == 0) __hip_atomic_fetch_add(cnt, 1u, __ATOMIC_RELAXED, __HIP_MEMORY_SCOPE_AGENT);
    if (wid == 0) {
        unsigned spins = 0; const unsigned want = 8u * (unsigned)nparts;
        for (;;) {
            if ((unsigned)__builtin_amdgcn_readfirstlane(__hip_atomic_load(cnt, __ATOMIC_RELAXED, __HIP_MEMORY_SCOPE_AGENT)) >= want) break;
            if (++spins > (1u << 22)) break;
            __builtin_amdgcn_s_sleep(2);
        }
        __builtin_amdgcn_fence(__ATOMIC_ACQUIRE, "agent");
    }
    asm volatile("s_waitcnt vmcnt(0) lgkmcnt(0)" ::: "memory");
    __syncthreads();
    if (tid < rows) { float t = 0.f; for (int q = 0; q < nparts; ++q) t += __hip_atomic_load(slots + (size_t)tid * nparts + q, __ATOMIC_RELAXED, __HIP_MEMORY_SCOPE_AGENT); totL[tid] = t; }
    __syncthreads();
}
__device__ __forceinline__ void skinny_norm(f32x4 (&o)[2], int part, const float* base, float* out, bf16_t* xn, float* ssq_s, const float* gain, float* slots1, unsigned* cnt1, float* ldsf) {
    const int tid = tidx(), w = tid >> 6, lane = tid & 63, r32 = lane & 31, h = lane >> 5;
    float* tmp = ldsf; float* partL = ldsf + 256; float* totL = ldsf + 384;
    const int row = 32 * (w >> 1) + r32; const int c0 = part * 32 + 16 * (w & 1) + 4 * h;
    float s = 0.f;
#pragma unroll
    for (int g = 0; g < 2; ++g) s += (o[g].x * o[g].x + o[g].y * o[g].y) + (o[g].z * o[g].z + o[g].w * o[g].w);
    skinny_rowsum(s, tmp, partL);
    row_exchange(slots1, cnt1, 32, part, 128, partL, totL);
    const float rs1 = 1.0f / sqrtf(totL[row] * (1.0f / 1024.0f) + 1e-6f);
    f32x4 x1[2]; float s2 = 0.f;
#pragma unroll
    for (int g = 0; g < 2; ++g) { const int c = c0 + 8 * g; const f32x4 gv = *(const f32x4*)(gain + c); const f32x4 bs = *(const f32x4*)(base + (size_t)row * 1024 + c); x1[g] = bs + o[g] * gv * rs1;
        s2 += (x1[g].x * x1[g].x + x1[g].y * x1[g].y) + (x1[g].z * x1[g].z + x1[g].w * x1[g].w);
        *(f32x4*)(out + (size_t)row * 1024 + c) = x1[g];
        if (xn) { u32x2 wv; wv.x = pk2(x1[g].x, x1[g].y); wv.y = pk2(x1[g].z, x1[g].w); *(u32x2*)(xn + foff(row, c, 1024)) = wv; } }
    if (xn) { __syncthreads(); skinny_rowsum(s2, tmp, partL); if (tid < 128) ssq_s[tid * 32 + part] = partL[tid]; }
    __syncthreads();
}
__device__ __forceinline__ float sample_rs(const float* ssq_s, int row) {
    const f32x4* q = (const f32x4*)(ssq_s + row * 32); float t = 0.f;
#pragma unroll
    for (int i = 0; i < 8; ++i) { const f32x4 v = q[i]; t += (v.x + v.y) + (v.z + v.w); }
    return 1.0f / sqrtf(t * (1.0f / 1024.0f) + 1e-6f);
}
__device__ __forceinline__ void panel_rs(const float* ssq, int pm, float* rsL) {
    const int tid = tidx();
    if (tid < 256) { const f32x4* q = (const f32x4*)(ssq + (size_t)(pm * 256 + tid) * 16); float t = 0.f;
#pragma unroll
        for (int i = 0; i < 4; ++i) { const f32x4 v = q[i]; t += (v.x + v.y) + (v.z + v.w); }
        rsL[tid] = 1.0f / sqrtf(t * (1.0f / 1024.0f) + 1e-6f); }
    __syncthreads();
}

__device__ __forceinline__ int vpos(int row) { return (row & ~12) | ((row & 4) << 1) | ((row & 8) >> 1); }
__device__ __forceinline__ void fox_bias(float* biasL, float* wsum, const float* s1, int n1, const float* s2, int n, int npad);
template <int HD, bool FOX, bool F32KV = false>
__device__ __forceinline__ void attn_unit(unsigned char* lds, const bf16_t* Q, int ldq, int nq_valid, const bf16_t* Kp, const bf16_t* Vp, int ldk, int n_keys, int qpos0,
                                          const float* biasL, bf16_t* O, int ldo, const float* Kf = nullptr, const float* Vf = nullptr, int nf32 = 0, int frow0 = -1, int fcol0 = 0,
                                          const float* fb_s1 = nullptr, int fb_n1 = 0, const float* fb_s2 = nullptr, int fb_npad = 0, float* fb_wsum = nullptr) {
    constexpr int KT = (HD == 64 && !F32KV) ? 128 : 64, NTT = KT / 32, NKS = KT / 16;
    constexpr int KP = HD * 2 + 16, VP = HD * 2 + 64, KBY = KT * KP, VBY = KT * VP, BUF = KBY + VBY;
    constexpr int CH = HD / 8, NL = (KT * CH) / NTHR, ND = HD / 16, NO = HD / 32; constexpr bool DEEP = (HD == 64) && !F32KV && (KT == 64);
    const int tid = tidx(), w = __builtin_amdgcn_readfirstlane(tid >> 6), lane = tid & 63, r32 = lane & 31, h = lane >> 5;
    int qrow = 32 * w + r32; if (qrow >= nq_valid) qrow = nq_valid - 1;
    bf16x8 qf[ND];
#pragma unroll
    for (int d0 = 0; d0 < ND; ++d0) qf[d0] = *(const bf16x8*)(Q + (size_t)qrow * ldq + 16 * d0 + 8 * h);
    const bool wave_active = (32 * w < nq_valid);
    const int qpos = qpos0 + 32 * w + r32;
    f32x16 o[NO];
#pragma unroll
    for (int i = 0; i < NO; ++i)
#pragma unroll
        for (int r = 0; r < 16; ++r) o[i][r] = 0.f;
    float m_run = -1e30f, l_run = 0.f;
    const int NT = (n_keys + KT - 1) / KT;
    u32x4 krA[NL], vrA[NL], krB[NL], vrB[NL]; f32x4 kraw[2], vraw[2];
#define ATT_GLOAD(t, kr, vr) do { if (F32KV && (t) < nf32) { const int row_ = tid / CH, ch_ = tid % CH; const size_t go_ = (size_t)((t) * 64 + row_) * 512 + ch_ * 8; \
        kraw[0] = __builtin_nontemporal_load((const f32x4*)(Kf + go_)); kraw[1] = __builtin_nontemporal_load((const f32x4*)(Kf + go_ + 4)); vraw[0] = __builtin_nontemporal_load((const f32x4*)(Vf + go_)); vraw[1] = __builtin_nontemporal_load((const f32x4*)(Vf + go_ + 4)); } else { \
        _Pragma("unroll") for (int i_ = 0; i_ < NL; ++i_) { const int idx_ = tid + NTHR * i_, row_ = idx_ / CH, ch_ = idx_ % CH; const size_t go_ = (size_t)(((t) - nf32) * KT + row_) * ldk + ch_ * 8; \
        kr[i_] = *(const u32x4*)(Kp + go_); vr[i_] = *(const u32x4*)(Vp + go_); } } } while (0)
#define ATT_LWRITE(buf, t, kr, vr) do { if (F32KV && (t) < nf32) { kr[0].x = pk2(kraw[0].x, kraw[0].y); kr[0].y = pk2(kraw[0].z, kraw[0].w); kr[0].z = pk2(kraw[1].x, kraw[1].y); kr[0].w = pk2(kraw[1].z, kraw[1].w); \
        vr[0].x = pk2(vraw[0].x, vraw[0].y); vr[0].y = pk2(vraw[0].z, vraw[0].w); vr[0].z = pk2(vraw[1].x, vraw[1].y); vr[0].w = pk2(vraw[1].z, vraw[1].w); } \
        unsigned char* kb_ = lds + (buf) * BUF; unsigned char* vb_ = kb_ + KBY; _Pragma("unroll") for (int i_ = 0; i_ < NL; ++i_) { const int idx_ = tid + NTHR * i_, row_ = idx_ / CH, ch_ = idx_ % CH; \
        *(u32x4*)(kb_ + row_ * KP + ch_ * 16) = kr[i_]; *(u32x4*)(vb_ + row_ * VP + ch_ * 16) = vr[i_]; } } while (0)
#define ATT_COMPUTE(TT_) do { const int t = (TT_); \
        const bool doit = wave_active && (!FOX || (t * KT <= qpos0 + 32 * w + 31)); \
        if (doit) { \
            const unsigned char* Kb = lds + (t & 1) * BUF; const unsigned char* Vb = Kb + KBY; \
            f32x16 p[NTT]; \
_Pragma("unroll") \
            for (int tt = 0; tt < NTT; ++tt) { \
                f32x16 c; \
                if (FOX) { \
_Pragma("unroll") \
                    for (int g = 0; g < 4; ++g) { const f32x4 bv = *(const f32x4*)(biasL + t * KT + 32 * tt + 8 * g + 4 * h); c[4 * g] = bv.x; c[4 * g + 1] = bv.y; c[4 * g + 2] = bv.z; c[4 * g + 3] = bv.w; } \
                } else { \
_Pragma("unroll") \
                    for (int r = 0; r < 16; ++r) c[r] = 0.f; \
                } \
_Pragma("unroll") \
                for (int d0 = 0; d0 < ND; ++d0) { const bf16x8 a = *(const bf16x8*)(Kb + (32 * tt + r32) * KP + (16 * d0 + 8 * h) * 2); c = MFMA32(a, qf[d0], c); } \
                p[tt] = c; \
            } \
            if (FOX && (t * KT + KT - 1 > qpos0 + 32 * w)) { \
                const int qrel = qpos - t * KT - 4 * h; \
_Pragma("unroll") \
                for (int tt = 0; tt < NTT; ++tt) \
_Pragma("unroll") \
                    for (int r = 0; r < 16; ++r) { if (32 * tt + (r & 3) + 8 * (r >> 2) > qrel) p[tt][r] = -__builtin_inff(); } \
            } \
            float mx = 0.f; \
_Pragma("unroll") \
            for (int tt = 0; tt < NTT; ++tt) { float ma = fmaxf(fmaxf(p[tt][0], p[tt][1]), p[tt][2]); \
_Pragma("unroll") \
                for (int r = 3; r < 15; r += 2) ma = fmaxf(fmaxf(ma, p[tt][r]), p[tt][r + 1]); \
                ma = fmaxf(ma, p[tt][15]); mx = tt == 0 ? ma : fmaxf(mx, ma); } \
            { auto rr = __builtin_amdgcn_permlane32_swap(__float_as_uint(mx), __float_as_uint(mx), false, false); mx = fmaxf(__uint_as_float(rr[0]), __uint_as_float(rr[1])); } \
            if (__any(mx > m_run + 20.0f)) { \
                const float mnew = fmaxf(m_run, mx); const float alpha = __builtin_amdgcn_exp2f(m_run - mnew); \
                l_run *= alpha; m_run = mnew; \
_Pragma("unroll") \
                for (int i = 0; i < NO; ++i) o[i] = o[i] * alpha; \
            } \
            f32x2v ls2 = (f32x2v){0.f, 0.f}; const f32x2v nm2 = (f32x2v){-m_run, -m_run}; \
_Pragma("unroll") \
            for (int tt = 0; tt < NTT; ++tt) \
_Pragma("unroll") \
                for (int r = 0; r < 16; r += 2) { f32x2v x = (f32x2v){p[tt][r], p[tt][r + 1]} + nm2; x.x = __builtin_amdgcn_exp2f(x.x); x.y = __builtin_amdgcn_exp2f(x.y); p[tt][r] = x.x; p[tt][r + 1] = x.y; ls2 += x; } \
            l_run += ls2.x + ls2.y; \
_Pragma("unroll") \
            for (int ks = 0; ks < NKS; ++ks) { \
                const int tt = ks >> 1, s = ks & 1; \
                u32x4 pw; pw.x = pk2(p[tt][8 * s + 0], p[tt][8 * s + 1]); pw.y = pk2(p[tt][8 * s + 2], p[tt][8 * s + 3]); pw.z = pk2(p[tt][8 * s + 4], p[tt][8 * s + 5]); pw.w = pk2(p[tt][8 * s + 6], p[tt][8 * s + 7]); \
                const bf16x8 pb = __builtin_bit_cast(bf16x8, pw); \
_Pragma("unroll") \
                for (int db = 0; db < NO; ++db) { \
                    const LAS3 unsigned char* vp = (const LAS3 unsigned char*)Vb + (32 * tt + 16 * s + 4 * h + ((lane & 15) >> 2)) * VP + 64 * db + 8 * (4 * ((lane >> 4) & 1) + (lane & 3)); \
                    const s16x4v lo = __builtin_amdgcn_ds_read_tr16_b64_v4i16((LAS3 s16x4v*)vp), hi = __builtin_amdgcn_ds_read_tr16_b64_v4i16((LAS3 s16x4v*)(vp + 8 * VP)); \
                    const bf16x8 av = (bf16x8){lo[0], lo[1], lo[2], lo[3], hi[0], hi[1], hi[2], hi[3]}; \
                    o[db] = MFMA32(av, pb, o[db]); \
                } \
            } \
        } \
    } while (0)
    ATT_GLOAD(0, krA, vrA);
    if (FOX) fox_bias((float*)biasL, fb_wsum, fb_s1, fb_n1, fb_s2, n_keys, fb_npad);
    __syncthreads();
    ATT_LWRITE(0, 0, krA, vrA);
    __syncthreads();
    if (DEEP) {
        if (1 < NT) ATT_GLOAD(1, krA, vrA);
        for (int tl = 0; tl < NT; tl += 2) {
            if (tl + 2 < NT) ATT_GLOAD(tl + 2, krB, vrB);
            ATT_COMPUTE(tl);
            if (tl + 1 < NT) ATT_LWRITE((tl + 1) & 1, tl + 1, krA, vrA);
            __syncthreads();
            if (tl + 1 < NT) {
                if (tl + 3 < NT) ATT_GLOAD(tl + 3, krA, vrA);
                ATT_COMPUTE(tl + 1);
                if (tl + 2 < NT) ATT_LWRITE(tl & 1, tl + 2, krB, vrB);
                __syncthreads();
            }
        }
    } else {
        for (int tl = 0; tl < NT; ++tl) {
            if (tl + 1 < NT) ATT_GLOAD(tl + 1, krA, vrA);
            ATT_COMPUTE(tl);
            if (tl + 1 < NT) ATT_LWRITE((tl + 1) & 1, tl + 1, krA, vrA);
            __syncthreads();
        }
    }
#undef ATT_COMPUTE
#undef ATT_GLOAD
#undef ATT_LWRITE
    const float lt = l_run + __shfl_xor(l_run, 32);
    const float inv = 1.0f / lt;
    if (32 * w + r32 < nq_valid) {
        bf16_t* op = O + (size_t)(32 * w + r32) * ldo;
#pragma unroll
        for (int db = 0; db < NO; ++db)
#pragma unroll
            for (int g = 0; g < 4; ++g) { u32x2 wv; wv.x = pk2(o[db][4 * g] * inv, o[db][4 * g + 1] * inv); wv.y = pk2(o[db][4 * g + 2] * inv, o[db][4 * g + 3] * inv);
                if (frow0 < 0) *(u32x2*)(op + 32 * db + 8 * g + 4 * h) = wv; else *(u32x2*)(O + foff(frow0 + 32 * w + r32, fcol0 + 32 * db + 8 * g + 4 * h, 1024)) = wv; }
    }
}

__device__ __forceinline__ void fox_bias(float* biasL, float* wsum  , const float* s1, int n1, const float* s2, int n, int npad) {
    const int tid = tidx(), lane = tid & 63, w = tid >> 6;
    float v[9]; float run = 0.f;
#pragma unroll
    for (int i = 0; i < 9; ++i) { const int p = tid * 9 + i; float x = 0.f; if (p < n) x = (p < n1) ? s1[(size_t)p * 8] : s2[(size_t)(p - n1) * 8]; run += x; v[i] = run; }
    float incl = run;
#pragma unroll
    for (int off = 1; off < 64; off <<= 1) { const float y = __shfl_up(incl, off); if (lane >= off) incl += y; }
    if (lane == 63) wsum[w] = incl;
    __syncthreads();
    float base = incl - run;
    for (int ww = 0; ww < w; ++ww) base += wsum[ww];
#pragma unroll
    for (int i = 0; i < 9; ++i) { const int p = tid * 9 + i; if (p < npad) biasL[p] = (p < n) ? -(base + v[i]) * LOG2E : 0.f; }
    __syncthreads();
}

__device__ __forceinline__ void pool_unit(unsigned char* lds, const Params& p, int unit) {
    const int tid = tidx(), w = tid >> 6, lane = tid & 63, r32 = lane & 31, h = lane >> 5;
    constexpr int XP = 272;
    unsigned char* X = lds; unsigned char* Ap = lds + 144 * XP;
    const bf16_t* MI = (const bf16_t*)(p.ws + WS_MI); bf16_t* CAT = (bf16_t*)(p.ws + WS_CAT); const bf16_t* WpT = (const bf16_t*)(p.ws + WS_WPOOL);
    const float* scale = p.in[16];
    int g, b, t0, nrows, rowbase; bool sample;
    if (unit < 512) { const int tile = unit >> 2; g = unit & 3; b = tile >> 5; t0 = (tile & 31) * 128; nrows = 128; rowbase = b * SEQ; sample = false; }
    else { const int s = unit - 512; b = s >> 2; g = s & 3; t0 = 0; nrows = 16; rowbase = MP + b * DS; sample = true; }
    const int win = 2 << g;
    for (int idx = tid; idx < (15 + nrows) * 16; idx += NTHR) {
        const int j = idx >> 4, ch = idx & 15; const int t = t0 - 15 + j; u32x4 v = (u32x4){0u, 0u, 0u, 0u};
        if (!sample) { if (t >= 0) v = *(const u32x4*)(MI + (size_t)(rowbase + t) * 512 + g * 128 + ch * 8); }
        else if (j < 15) { const float* cp = p.in[2] + ((size_t)(b * 15 + j) * 512 + g * 128 + ch * 8); const f32x4 a = *(const f32x4*)cp, c = *(const f32x4*)(cp + 4);
            v.x = pk2(a.x, a.y); v.y = pk2(a.z, a.w); v.z = pk2(c.x, c.y); v.w = pk2(c.z, c.w); }
        else v = *(const u32x4*)(MI + (size_t)(rowbase + (j - 15)) * 512 + g * 128 + ch * 8);
        *(u32x4*)(X + j * XP + ch * 16) = v;
    }
    __syncthreads();
    if (sample) { for (int idx = tid; idx < 15 * 128; idx += NTHR) { const int i = idx >> 7, c = idx & 127; p.out[O_PSS + (size_t)(b * 15 + i) * 512 + g * 128 + c] = bf2f(*(const unsigned short*)(X + (16 + i) * XP + c * 2)); } }
    else if (t0 == SEQ - 128) { for (int idx = tid; idx < 15 * 128; idx += NTHR) { const int i = idx >> 7, c = idx & 127; p.out[O_PSP + (size_t)(b * 15 + i) * 512 + g * 128 + c] = bf2f(*(const unsigned short*)(X + (128 + i) * XP + c * 2)); } }
    {
        const int c = tid & 127, r0 = (tid >> 7) * 32;
        if (r0 < nrows) {
            const int nr = (nrows - r0) < 32 ? (nrows - r0) : 32;
            float s = 0.f;
            for (int j = 1; j < win; ++j) s += bf2f(*(const unsigned short*)(X + (15 + r0 - j) * XP + c * 2));
            for (int t = r0; t < r0 + nr; ++t) {
                const float xv = bf2f(*(const unsigned short*)(X + (15 + t) * XP + c * 2)); s += xv;
                int cnt = win; if (!sample) { const int ta = t0 + t + 1; cnt = ta < win ? ta : win; }
                const float pooled = s / (float)cnt - xv;
                *(unsigned short*)(Ap + t * XP + c * 2) = f2bf(pooled);
                s -= bf2f(*(const unsigned short*)(X + (15 + t - (win - 1)) * XP + c * 2));
            }
        }
    }
    __syncthreads();
    {
        const int tb = w & 3, dh = w >> 2;
        if (32 * tb < nrows) {
            f32x16 acc[2];
#pragma unroll
            for (int i = 0; i < 2; ++i)
#pragma unroll
                for (int r = 0; r < 16; ++r) acc[i][r] = 0.f;
#pragma unroll
            for (int ks = 0; ks < 8; ++ks) {
                const bf16x8 bfr = *(const bf16x8*)(Ap + (32 * tb + r32) * XP + (16 * ks + 8 * h) * 2);
#pragma unroll
                for (int db = 0; db < 2; ++db) { const bf16x8 a = *(const bf16x8*)(WpT + ((size_t)(g * 128 + 64 * dh + 32 * db + r32) * 128 + 16 * ks + 8 * h)); acc[db] = MFMA32(a, bfr, acc[db]); }
            }
            const int t = 32 * tb + r32;
            if (t < nrows) {
                bf16_t* op = CAT + (size_t)(rowbase + t0 + t) * 1024 + g * 128; bf16_t* opf = CAT + (size_t)MP * 1024;
#pragma unroll
                for (int db = 0; db < 2; ++db)
#pragma unroll
                    for (int q = 0; q < 4; ++q) { const int d = 64 * dh + 32 * db + 8 * q + 4 * h; const f32x4 sc = *(const f32x4*)(scale + g * 128 + d);
                        u32x2 wv; wv.x = pk2(acc[db][4 * q] * sc.x, acc[db][4 * q + 1] * sc.y); wv.y = pk2(acc[db][4 * q + 2] * sc.z, acc[db][4 * q + 3] * sc.w);
                        if (!sample) *(u32x2*)(op + d) = wv; else *(u32x2*)(opf + foff(b * DS + t, g * 128 + d, 1024)) = wv; }
            }
        }
    }
    __syncthreads();
}

__device__ __forceinline__ void mem_unit(unsigned char* lds, const Params& p, int l, int unit) {
    const bf16_t* MQ = (const bf16_t*)(p.ws + WS_MQ); bf16_t* CAT = (bf16_t*)(p.ws + WS_CAT);
    size_t row0; int hd, nq, ldk; const bf16_t* k; const bf16_t* v;
    if (unit < 256) {
        const int b = unit >> 6, qb = unit & 15; hd = (unit >> 4) & 3; row0 = (size_t)b * SEQ + qb * 256; nq = 256; ldk = 1024;
        k = (const bf16_t*)(p.ws + WS_MKVP) + (size_t)l * 1024 * 1024 + (size_t)b * NMEM * 1024 + hd * 128; v = k + 512;
    } else {
        const int s = unit - 256, b = s >> 2; hd = s & 3; row0 = (size_t)MP + b * DS; nq = DS; ldk = 512;
        k = (const bf16_t*)(p.ws + WS_MKS) + ((size_t)l * DB * NMEM + (size_t)b * NMEM) * 512 + hd * 128;
        v = (const bf16_t*)(p.ws + WS_MVS) + ((size_t)l * DB * NMEM + (size_t)b * NMEM) * 512 + hd * 128;
    }
    if (unit < 256) attn_unit<128, false>(lds, MQ + row0 * 512 + hd * 128, 512, nq, k, v, ldk, NMEM, 0, nullptr, CAT + row0 * 1024 + 512 + hd * 128, 1024);
    else attn_unit<128, false>(lds, MQ + row0 * 512 + hd * 128, 512, nq, k, v, ldk, NMEM, 0, nullptr, CAT + (size_t)MP * 1024, 1024, nullptr, nullptr, 0, (int)(row0 - MP), 512 + hd * 128);
}
__device__ __forceinline__ void fox_unit(unsigned char* lds, const Params& p, int unit) {
    const bf16_t* MI = (const bf16_t*)(p.ws + WS_MI); bf16_t* CAT = (bf16_t*)(p.ws + WS_CAT);
    float* biasL = (float*)(lds + 86016); float* wsum = (float*)(lds + 86016 + 18432);
    size_t row0; int hd, nq, nk, n1, npad, qpos0, nf32 = 0; const float* s1; const float* s2; const bf16_t* k; const bf16_t* v; const float* kf = nullptr; const float* vf = nullptr;
    if (unit < 512) {
        const int qb = 15 - (unit >> 5), bh = unit & 31, b = bh >> 3; hd = bh & 7; const size_t rowb = (size_t)b * SEQ; nk = (qb + 1) * 256; n1 = nk; npad = nk; nq = 256; qpos0 = qb * 256;
        row0 = rowb + qb * 256; s1 = p.out + O_LFP + rowb * 8 + hd; s2 = s1;
        k = (const bf16_t*)(p.ws + WS_KB) + rowb * 512 + hd * 64; v = (const bf16_t*)(p.ws + WS_VB) + rowb * 512 + hd * 64;
    } else {
        const int s = unit - 512, b = s >> 3; hd = s & 7; row0 = (size_t)MP + b * DS; nk = PAST + DS; n1 = PAST; npad = LKS; nq = DS; qpos0 = PAST;
        s1 = p.in[5] + (size_t)b * PAST * 8 + hd; s2 = p.out + O_LFS + (size_t)b * DS * 8 + hd;
        k = (const bf16_t*)(p.ws + WS_KSB) + (size_t)b * NKS * 512 + hd * 64; v = (const bf16_t*)(p.ws + WS_VSB) + (size_t)b * NKS * 512 + hd * 64;
        kf = p.in[3] + (size_t)b * PAST * 512 + hd * 64; vf = p.in[4] + (size_t)b * PAST * 512 + hd * 64; nf32 = PAST / 64;
    }
    const bool smp = unit >= 512;
    if (!smp) attn_unit<64, true, false>(lds, MI + row0 * 512 + hd * 64, 512, nq, k, v, 512, nk, qpos0, biasL, CAT + row0 * 1024 + hd * 64, 1024, nullptr, nullptr, 0, -1, 0, s1, n1, s2, npad, wsum);
    else attn_unit<64, true, true>(lds, MI + row0 * 512 + hd * 64, 512, nq, k, v, 512, nk, qpos0, biasL, CAT + (size_t)MP * 1024, 1024, kf, vf, nf32, (int)(row0 - MP), hd * 64, s1, n1, s2, npad, wsum);
}

__device__ __forceinline__ void cvt_unit(unsigned char* lds, const Params& p, int unit) {
    const int tid = tidx(), lane = tid & 63, wave = __builtin_amdgcn_readfirstlane(tid >> 6);
    float* scr = (float*)(lds + wave * 16640);
    constexpr int I_SQ = 16 * 16, I_UP = 16 * 64, I_DN = 64 * 16;
    int r = unit * 8 + wave;
    const float* W; const float* gain = nullptr; bf16_t* WT; int K = 1024, N = 1024, ldw = 1024;
    if (r < I_SQ) { W = p.in[13] + 1048576; gain = p.in[9] + 1024; WT = (bf16_t*)(p.ws + WS_WINKV); }
    else if ((r -= I_SQ) < I_SQ) { W = p.in[18]; ldw = 1032; gain = p.in[17]; WT = (bf16_t*)(p.ws + WS_WINKV) + 1048576; }
    else if ((r -= I_SQ) < I_SQ) { W = p.in[14]; WT = (bf16_t*)(p.ws + WS_WOUT); }
    else if ((r -= I_SQ) < I_SQ) { W = p.in[14] + 1048576; WT = (bf16_t*)(p.ws + WS_WOUT) + 1048576; }
    else if ((r -= I_SQ) < I_UP) { W = p.in[22]; N = 4096; ldw = 4096; gain = p.in[11]; WT = (bf16_t*)(p.ws + WS_WUP); }
    else if ((r -= I_UP) < I_UP) { W = p.in[22] + 4194304; N = 4096; ldw = 4096; gain = p.in[11] + 1024; WT = (bf16_t*)(p.ws + WS_WUP) + 4194304; }
    else if ((r -= I_UP) < I_DN) { W = p.in[23]; K = 4096; WT = (bf16_t*)(p.ws + WS_WDN); }
    else { r -= I_DN; W = p.in[23] + 4194304; K = 4096; WT = (bf16_t*)(p.ws + WS_WDN) + 4194304; }
    transpose_item(W, K, N, ldw, gain, WT, scr, r, lane);
}

#define LAS __attribute__((address_space(3)))
#define XB_TMO      128
#define XB_XCNT(j)  (256  + 64 * (j))
#define XB_XSUB(j)  (1280 + 64 * (j))
#define XB_XGEN(j)  (2304 + 64 * (j))
#define XB_TOP      3328
#define XB_TOPGEN   3392
#define XCD_BAR_WORDS 3456
#define XB_SPIN_CAP (1u << 18)

__device__ __forceinline__ unsigned xb_ld(unsigned* p)              { return __hip_atomic_load(p, __ATOMIC_RELAXED, __HIP_MEMORY_SCOPE_AGENT); }
__device__ __forceinline__ unsigned xb_add(unsigned* p, unsigned v) { return __hip_atomic_fetch_add(p, v, __ATOMIC_RELAXED, __HIP_MEMORY_SCOPE_AGENT); }
__device__ __forceinline__ unsigned xb_xcc_id() { return (unsigned)__builtin_amdgcn_s_getreg((3 << 11) | 20) & 0xFu; }
#define XB_SPIN(cond, bar) do { unsigned _sp = 0; while (cond) { __builtin_amdgcn_s_sleep(1); \
    if ((++_sp & 255u) == 0u) { if (xb_ld(&(bar)[XB_TMO])) break; if (_sp > XB_SPIN_CAP) { atomicAdd(&(bar)[XB_TMO], 1u); break; } } } } while (0)

struct XcdBarrier {
    unsigned* bar; unsigned x;
    volatile LAS unsigned* st;
};

__device__ __forceinline__ XcdBarrier xcd_barrier_post(unsigned* bar, volatile LAS unsigned* st) {
    XcdBarrier b; b.bar = bar; b.x = xb_xcc_id(); b.st = st;
    if (tidx() == 0) (void)xb_add(&bar[XB_XCNT(b.x)], 1u);
    return b;
}
__device__ __forceinline__ void xcd_barrier_complete(unsigned* bar, unsigned x, unsigned& nloc, unsigned& nx) {
    const unsigned G = gridDim.x * gridDim.y * gridDim.z;
    unsigned sum, cnt, mine, sp = 0u;
    for (;;) {
        sum = 0u; cnt = 0u; mine = 0u;
#pragma unroll
        for (unsigned j = 0; j < 16; ++j) { const unsigned c = xb_ld(&bar[XB_XCNT(j)]); sum += c; cnt += (c > 0u) ? 1u : 0u; mine = (j == x) ? c : mine; }
        if (sum == G) break;
        __builtin_amdgcn_s_sleep(1);
        if ((++sp & 255u) == 0u) { if (xb_ld(&bar[XB_TMO])) break; if (sp > XB_SPIN_CAP) { atomicAdd(&bar[XB_TMO], 1u); break; } }
    }
    nloc = mine > 0u ? mine : 1u; nx = cnt > 0u ? cnt : 1u;
}

__device__ __forceinline__ void xcd_barrier(const XcdBarrier& b) {
    asm volatile("s_waitcnt vmcnt(0)" ::: "memory");
    __syncthreads();
    if (tidx() == 0) {
        unsigned* bar = b.bar;
        __builtin_amdgcn_s_waitcnt(0);
        unsigned nloc = b.st[0], nx = b.st[1];
        if (nloc == 0u) { xcd_barrier_complete(bar, b.x, nloc, nx); b.st[0] = nloc; b.st[1] = nx; }
        const unsigned old = xb_add(&bar[XB_XSUB(b.x)], 1u);
        const unsigned gen = old / nloc;
        if (old + 1u == (gen + 1u) * nloc) {
            __builtin_amdgcn_fence(__ATOMIC_RELEASE, "agent");
            asm volatile("s_waitcnt vmcnt(0)" ::: "memory");
            const unsigned og = xb_add(&bar[XB_TOP], 1u);
            const unsigned tg = og / nx;
            if (og + 1u == (tg + 1u) * nx) xb_add(&bar[XB_TOPGEN], 1u);
            else XB_SPIN(xb_ld(&bar[XB_TOPGEN]) == tg, bar);
            __builtin_amdgcn_fence(__ATOMIC_ACQUIRE, "agent");
            xb_add(&bar[XB_XGEN(b.x)], 1u);
            asm volatile("s_waitcnt vmcnt(0)" ::: "memory");
        } else {
            XB_SPIN(xb_ld(&bar[XB_XGEN(b.x)]) == gen, bar);
            __builtin_amdgcn_fence(__ATOMIC_ACQUIRE, "agent");
            asm volatile("s_waitcnt vmcnt(0)" ::: "memory");
        }
    }
    __syncthreads();
}

#ifndef ENMASK
#define ENMASK 63
#endif
#define EN(t) (((ENMASK) >> (t)) & 1)
#define IN(k) (lo <= (k) && (k) < hi)
#define SEAM(k) do { if (IN(k) && IN((k) + 1)) xcd_barrier(bar); } while (0)
template <int l>
__device__ __forceinline__ void layer_phases(const Params& p, unsigned char* lds, const XcdBarrier& bar, int lo, int hi) {
    const int tid = tidx(), lane = tid & 63, wave = __builtin_amdgcn_readfirstlane(tid >> 6);
    const int G = gridDim.x, bx = blockIdx.x;
    unsigned* ctl = (unsigned*)(p.ws + WS_CTL);
    float* slots = (float*)(p.ws + WS_SLOTS);
    int* qslot = (int*)(lds + MISC_OFF);
    float* ldsf = (float*)lds;
    PG8_LAS unsigned char* lds3 = (PG8_LAS unsigned char*)lds;
    bf16_t* XN = (bf16_t*)(p.ws + WS_XN);
    float* X = p.out + O_Y;
    float* ssq = (float*)(p.ws + WS_SSQ); float* ssq_s = ssq + (size_t)MP * 16;
    float* rsL = (float*)(lds + RING_BYTES); const PG8_LAS float* rsL3 = (const PG8_LAS float*)(lds3 + RING_BYTES);
    (void)wave; (void)ctl; (void)slots; (void)qslot;
        const int pb = 1 + 5 * l;
        if (EN(1) && IN(pb)) {
            bf16_t* MIb = (bf16_t*)(p.ws + WS_MI); bf16_t* MQb = (bf16_t*)(p.ws + WS_MQ);
            const float smi = l == 0 ? 1.f : CFOX, smq = CMEM;
            const int nsk_s = l == 0 ? 32 : 64, nsk = l == 0 ? 32 + 512 : 64 + 129;
#ifndef PROBE_SK
#define PROBE_SK 1
#endif
            for (int reps = 0; reps < PROBE_SK; ++reps)
            for (int u = bx; u < nsk; u += G) {
                f32x4 o[2];
                if (u < nsk_s) {
                    skinny_gemm(XN + (size_t)MP * DM, (const bf16_t*)(p.ws + (l == 0 ? WS_WIN0 : WS_WINKV)), 1024, 0, u * 32, ldsf, o);
                    const int w = tid >> 6, r32 = lane & 31, h = lane >> 5; const int row = 32 * (w >> 1) + r32;
                    const float rsr = l == 1 ? sample_rs(ssq_s, row) : 1.f;
#pragma unroll
                    for (int g = 0; g < 2; ++g) { const int col = u * 32 + 16 * (w & 1) + 8 * g + 4 * h; const int sec = col >> 9, cc = col & 511; const f32x4 v = o[g] * rsr;
                        if (sec < 2) { const float sc = sec == 0 ? smi : smq; u32x2 wv; wv.x = pk2(v.x * sc, v.y * sc); wv.y = pk2(v.z * sc, v.w * sc); *(u32x2*)((sec == 0 ? MIb : MQb) + (size_t)(MP + row) * 512 + cc) = wv; }
                        else { *(f32x4*)(p.out + (sec == 2 ? O_KS : O_VS) + (size_t)row * 512 + cc) = v; u32x2 wv; wv.x = pk2(v.x, v.y); wv.y = pk2(v.z, v.w);
                            *(u32x2*)((bf16_t*)(p.ws + (sec == 2 ? WS_KSB : WS_VSB)) + ((size_t)(row >> 4) * NKS + (row & 15)) * 512 + cc) = wv; } }
                } else if (l == 1) {
                    const int ug = u - 64;
                    if (ug < 128) skinny_gemm<false>(XN, (const bf16_t*)(p.ws + WS_WF), 1024, ug * 128, 0, ldsf, o);
                    else skinny_gemm<true>(XN + (size_t)MP * DM, (const bf16_t*)(p.ws + WS_WF), 1024, 0, 0, ldsf, o);
                    const int w = tid >> 6, r32 = lane & 31, h = lane >> 5; const int m = ug * 128 + 32 * (w >> 1) + r32;
                    float rsm;
                    if (m < MP) { const f32x4* q = (const f32x4*)(ssq + (size_t)m * 16); float t = 0.f;
#pragma unroll
                        for (int i = 0; i < 4; ++i) { const f32x4 v = q[i]; t += (v.x + v.y) + (v.z + v.w); }
                        rsm = 1.0f / sqrtf(t * (1.0f / 1024.0f) + 1e-6f); }
                    else rsm = sample_rs(ssq_s, m - MP);
                    if ((w & 1) == 0) { const f32x4 bfv = *(const f32x4*)(p.in[19] + 4 * h); f32x4 lf;
#pragma unroll
                        for (int e = 0; e < 4; ++e) { const float v = o[0][e] * rsm + bfv[e]; lf[e] = fminf(v, 0.f) - log1pf(expf(-fabsf(v))); }
                        if (m < MP) *(f32x4*)(p.out + O_LFP + (size_t)m * 8 + 4 * h) = lf; else *(f32x4*)(p.out + O_LFS + (size_t)(m - MP) * 8 + 4 * h) = lf; }
                } else {
                    const int v_ = u - 32, ly = v_ >> 8, rg = (v_ >> 5) & 7, cu = v_ & 31;
                    skinny_gemm((const bf16_t*)(p.ws + WS_MN), (const bf16_t*)(p.ws + WS_WMEM) + (size_t)ly * 1048576, 1024, rg * 128, cu * 32, ldsf, o);
                    const int w = tid >> 6, r32 = lane & 31, h = lane >> 5; const int row = rg * 128 + 32 * (w >> 1) + r32;
#pragma unroll
                    for (int g = 0; g < 2; ++g) { const int col = cu * 32 + 16 * (w & 1) + 8 * g + 4 * h; const f32x4 v = o[g];
                        *(f32x4*)(p.out + (col < 512 ? O_MK : O_MV) + (size_t)ly * 524288 + (size_t)row * 512 + (col & 511)) = v;
                        u32x2 wv; wv.x = pk2(v.x, v.y); wv.y = pk2(v.z, v.w); *(u32x2*)((bf16_t*)(p.ws + WS_MKVP) + (size_t)ly * 1048576 + (size_t)row * 1024 + col) = wv; }
                }
            }
            __syncthreads();
            pg8::Gemm g{XN, (const bf16_t*)(p.ws + (l == 0 ? WS_WIN0 : WS_WINKV)), MP, l == 0 ? 1024 : 2048, 1024};
            pg8::StaticOrder S; S.init(MP, g.N, G, bx);
            if (l == 1) { pg8::Unit u0; if (S.next(0, u0)) panel_rs(ssq, u0.pm, rsL); else __syncthreads(); }
            pg8::EpiProj E{MIb, MQb, (bf16_t*)(p.ws + WS_KB), (bf16_t*)(p.ws + WS_VB), p.out + O_KP, p.out + O_VP, smi, smq, l == 1 ? rsL3 : (const PG8_LAS float*)nullptr};
            pg8::gemm_phase<pg8::EpiProj, pg8::StaticOrder, true, true>(lds3, g, S, E);
#ifndef PROBE_PROJ
#define PROBE_PROJ 1
#endif
            if (PROBE_PROJ > 1 && l == 0) { __syncthreads(); pg8::gemm_phase<pg8::EpiProj, pg8::StaticOrder, true, true>(lds3, g, S, E); }
        }
        SEAM(pb);
        if (EN(2) && IN(pb + 1)) {
#ifndef PROBE_MIX
#define PROBE_MIX 1
#endif
            #ifndef PROBE_MIX_L
#define PROBE_MIX_L 1
#endif
            for (int rep = 0; rep < (l == PROBE_MIX_L ? PROBE_MIX : 1); ++rep) {
            unsigned* qc = ctl + CW_Q + 64 * (l + 2 * rep);
            const int nunits = l == 0 ? (640 + 256 + 544 + 32) : (576 + 288);
            for (;;) {
                __syncthreads();
                if (tid == 0) *qslot = (int)atomicAdd(qc, 1u);
                __syncthreads();
                const int u = *qslot;
                if (u >= nunits) break;
                if (l == 0) { const bool cv = u < 1280 && (u & 1) == 0; const int cu = u < 1280 ? (u >> 1) : u - 640;
                    if (cv) cvt_unit(lds, p, u >> 1); else if (cu >= 256 && cu < 800) pool_unit(lds, p, cu - 256); else mem_unit(lds, p, 0, cu < 256 ? cu : cu - 544); }
                else { if (u < 576) fox_unit(lds, p, u < 64 ? 512 + u : u - 64); else mem_unit(lds, p, 1, u - 576); }
            }
            }
            __syncthreads();
        }
        SEAM(pb + 1);
        if (EN(3) && IN(pb + 2)) {
            const float* bases = l == 0 ? p.in[1] : X + (size_t)MP * DM;
            const int bk = 2 * l;
            float* sl1 = slots + (size_t)bk * SLOT_BANK; unsigned* c1 = ctl + CW_CNT + bk * 80 * 64;
            const bf16_t* Wt = (const bf16_t*)(p.ws + WS_WOUT) + (size_t)l * 1048576;
            for (int u = bx; u < 32; u += G) {
                f32x4 o[2];
                skinny_gemm((const bf16_t*)(p.ws + WS_CAT) + (size_t)MP * DM, Wt, 1024, 0, u * 32, ldsf, o);
                skinny_norm(o, u, bases, X + (size_t)MP * DM, XN + (size_t)MP * DM, ssq_s, p.in[10] + l * 1024, sl1 + 65536, c1 + 64 * 64, ldsf);
            }
            __syncthreads();
            pg8::Gemm g{(const bf16_t*)(p.ws + WS_CAT), Wt, MP, 1024, 1024};
            pg8::StaticOrder S; S.init(MP, 1024, G, bx);
            if (l == 0) { pg8::EpiNorm<true, false> E{p.in[0], nullptr, XN, ssq, p.in[10] + l * 1024, sl1, c1}; pg8::gemm_phase<pg8::EpiNorm<true, false>, pg8::StaticOrder, false, true>(lds3, g, S, E); }
            else { pg8::EpiNorm<false, false> E{XN, nullptr, XN, ssq, p.in[10] + l * 1024, sl1, c1}; pg8::gemm_phase<pg8::EpiNorm<false, false>, pg8::StaticOrder, false, true>(lds3, g, S, E); }
        }
        SEAM(pb + 2);
        if (EN(4) && IN(pb + 3)) {
            const bf16_t* Wt = (const bf16_t*)(p.ws + WS_WUP) + (size_t)l * 4194304; bf16_t* HB = (bf16_t*)(p.ws + WS_HB);
            for (int reps = 0; reps < PROBE_SK; ++reps)
            for (int u = bx; u < 128; u += G) {
                f32x4 o[2];
                skinny_gemm(XN + (size_t)MP * DM, Wt, 1024, 0, u * 32, ldsf, o);
                const int w = tid >> 6, r32 = lane & 31, h = lane >> 5; const int row = 32 * (w >> 1) + r32; const float rsr = sample_rs(ssq_s, row);
#pragma unroll
                for (int g = 0; g < 2; ++g) { const int col = u * 32 + 16 * (w & 1) + 8 * g + 4 * h; f32x4 v = o[g];
#pragma unroll
                    for (int e = 0; e < 4; ++e) { const float a = (v[e] > 0.f ? v[e] : 0.f) * rsr; v[e] = a * a; }
                    u32x2 wv; wv.x = pk2(v.x, v.y); wv.y = pk2(v.z, v.w); *(u32x2*)(HB + (size_t)MP * FF + foff(row, col, FF)) = wv; }
            }
            __syncthreads();
            pg8::Gemm g{XN, Wt, MP, FF, 1024};
            pg8::StaticOrder S; S.init(MP, FF, G, bx);
            { pg8::Unit u0; if (S.next(0, u0)) panel_rs(ssq, u0.pm, rsL); else __syncthreads(); }
            pg8::EpiUp E{HB, FF, rsL3};
#ifndef PROBE_UP
#define PROBE_UP 1
#endif
            pg8::gemm_phase<pg8::EpiUp, pg8::StaticOrder, true, true>(lds3, g, S, E);
            if (PROBE_UP > 1 && l == 0) { __syncthreads(); pg8::gemm_phase<pg8::EpiUp, pg8::StaticOrder, true, true>(lds3, g, S, E); }
        }
        SEAM(pb + 3);
        if (EN(5) && IN(pb + 4)) {
            const int bk = 2 * l + 1;
            float* sl1 = slots + (size_t)bk * SLOT_BANK; unsigned* c1 = ctl + CW_CNT + bk * 80 * 64;
            const bf16_t* Wt = (const bf16_t*)(p.ws + WS_WDN) + (size_t)l * 4194304; const bf16_t* HB = (const bf16_t*)(p.ws + WS_HB);
            for (int u = bx; u < 32; u += G) {
                f32x4 o[2];
                skinny_gemm(HB + (size_t)MP * FF, Wt, FF, 0, u * 32, ldsf, o);
                skinny_norm(o, u, X + (size_t)MP * DM, X + (size_t)MP * DM, l == 0 ? XN + (size_t)MP * DM : nullptr, ssq_s, p.in[12] + l * 1024, sl1 + 65536, c1 + 64 * 64, ldsf);
            }
            __syncthreads();
            int Kd = FF; asm volatile("" : "+s"(Kd));
            pg8::Gemm g{HB, Wt, MP, 1024, Kd};
            pg8::StaticOrder S; S.init(MP, 1024, G, bx);
            if (l == 0) { pg8::EpiNorm<false, false> E{XN, nullptr, XN, ssq, p.in[12] + l * 1024, sl1, c1}; pg8::gemm_phase<pg8::EpiNorm<false, false>, pg8::StaticOrder, false, true>(lds3, g, S, E); }
            else { pg8::EpiNorm<false, true> E{XN, X, nullptr, nullptr, p.in[12] + l * 1024, sl1, c1}; pg8::gemm_phase<pg8::EpiNorm<false, true>, pg8::StaticOrder, false, true>(lds3, g, S, E); }
        }
        if (l == 0) SEAM(pb + 4);

}
__global__ void __launch_bounds__(NTHR, 2) yoco_fwd(Params p) {
    unsigned char* lds = lds_raw_;
    cg::grid_group grid = cg::this_grid();
    { const unsigned key = (unsigned)__builtin_amdgcn_s_getreg((5 << 11) | 4) & 63u; if ((threadIdx.x & 63) == 0) ((volatile int*)(lds_raw_ + TIDX_LDS_OFF))[key] = (int)(threadIdx.x >> 6); }
    __syncthreads();
    const int tid = tidx(), lane = tid & 63, wave = __builtin_amdgcn_readfirstlane(tid >> 6);
    const int G = gridDim.x, bx = blockIdx.x;
    unsigned* ctl = (unsigned*)(p.ws + WS_CTL);
    float* slots = (float*)(p.ws + WS_SLOTS);
    int* qslot = (int*)(lds + MISC_OFF);
    float* ldsf = (float*)lds;
    PG8_LAS unsigned char* lds3 = (PG8_LAS unsigned char*)lds;
    bf16_t* XN = (bf16_t*)(p.ws + WS_XN);
    float* X = p.out + O_Y;
    const int lo = p.ph_lo, hi = p.ph_hi;
    if (tid < 32) ((volatile unsigned*)(lds + MISC_OFF))[tid] = 0u;
    __syncthreads();
    XcdBarrier bar = xcd_barrier_post(ctl + CW_BAR, (volatile LAS unsigned*)(lds + MISC_OFF) + 8);

#ifndef PROBE_P0
#define PROBE_P0 1
#endif
    if (EN(0) && IN(0)) for (int rep0 = 0; rep0 < PROBE_P0; ++rep0) {
        float* scr = (float*)(lds + wave * 16640);
        const int gw = bx * 8 + wave, NGW = G * 8;
        constexpr int I_SQ = 16 * 16, I_PL = 2 * 2;
        constexpr int NITEMS = 3 * I_SQ + 4 * I_PL;
        for (int it = gw; it < NITEMS; it += NGW) {
            int r = it;
            if (r < I_SQ) { transpose_item(p.in[13], 1024, 1024, 1024, p.in[9], (bf16_t*)(p.ws + WS_WIN0), scr, r, lane); continue; } r -= I_SQ;
            if (r < I_SQ) { transpose_item(p.in[21], 1024, 1024, 1024, p.in[20], (bf16_t*)(p.ws + WS_WMEM), scr, r, lane); continue; } r -= I_SQ;
            if (r < I_SQ) { transpose_item(p.in[21] + 1048576, 1024, 1024, 1024, p.in[20] + 1024, (bf16_t*)(p.ws + WS_WMEM) + 1048576, scr, r, lane); continue; } r -= I_SQ;
            { const int gq = r / I_PL; transpose_item(p.in[15] + gq * 16384, 128, 128, 128, nullptr, (bf16_t*)(p.ws + WS_WPOOL) + gq * 16384, scr, r % I_PL, lane); }
        }
        for (int m = gw; m < MT + 1024; m += NGW) {
            if (m < MP) norm_row_to_bf16(p.in[0] + (size_t)m * DM, XN + (size_t)m * DM, lane);
            else if (m < MT) norm_row_to_bf16(p.in[1] + (size_t)(m - MP) * DM, XN + (size_t)MP * DM, lane, m - MP);
            else norm_row_to_bf16(p.in[8] + (size_t)(m - MT) * DM, (bf16_t*)(p.ws + WS_MN), lane, m - MT);
        }
        const size_t gtid = (size_t)bx * NTHR + tid, gn = (size_t)G * NTHR;
        cvt_rows(p.in[6], (bf16_t*)(p.ws + WS_MKS), (size_t)2 * DB * NMEM * 512 / 8, 64, 1, 1, gtid, gn);
        cvt_rows(p.in[7], (bf16_t*)(p.ws + WS_MVS), (size_t)2 * DB * NMEM * 512 / 8, 64, 1, 1, gtid, gn);
        for (size_t i = gtid; i < 32 * 1024; i += gn) { const int rr = (int)(i >> 10), k = (int)(i & 1023); const float v = rr < 8 ? p.in[17][k] * p.in[18][(size_t)k * 1032 + 1024 + rr] : 0.f; ((bf16_t*)(p.ws + WS_WF))[i] = f2bf(v); }
        __syncthreads();
    }
    SEAM(0);

    layer_phases<0>(p, lds, bar, lo, hi);
    layer_phases<1>(p, lds, bar, lo, hi);
    if (hi > 1000) grid.sync();
#undef IN
#undef SEAM
}

#ifndef MK_N_LAUNCHES
#define MK_N_LAUNCHES 1
#endif
extern "C" void kernel_launch(void* const* d_in, const int* in_sizes, int n_in, void* d_out, int out_size, void* d_ws, size_t ws_size, hipStream_t stream) {
    static int grid = 0;
    if (grid == 0) {
        if (n_in != 24 || ws_size < WS_END) { fprintf(stderr, "kernel_launch: unexpected problem (n_in %d, ws %zu)\n", n_in, ws_size); grid = -1; return; }
        int dev = 0, cus = 0, per_cu = 0;
        if (hipGetDevice(&dev) != hipSuccess || hipDeviceGetAttribute(&cus, hipDeviceAttributeMultiprocessorCount, dev) != hipSuccess) { grid = -1; return; }
        if (hipFuncSetAttribute((const void*)yoco_fwd, hipFuncAttributeMaxDynamicSharedMemorySize, LDS_BYTES) != hipSuccess) { fprintf(stderr, "kernel_launch: hipFuncSetAttribute failed\n"); grid = -1; return; }
        if (hipOccupancyMaxActiveBlocksPerMultiprocessor(&per_cu, (const void*)yoco_fwd, NTHR, LDS_BYTES) != hipSuccess || per_cu < 1) { fprintf(stderr, "kernel_launch: occupancy query says %d\n", per_cu); per_cu = 1; }
        (void)hipGetLastError();
        grid = cus;
        if (grid != 256) fprintf(stderr, "kernel_launch: %d CUs; this kernel is built for 256\n", grid);
    }
    if (grid < 0) return;
    (void)hipMemsetAsync((char*)d_ws + WS_CTL, 0, CTL_BYTES, stream);
    Params a{};
    for (int i = 0; i < 24; ++i) a.in[i] = (const float*)d_in[i];
    a.out = (float*)d_out; a.ws = (unsigned char*)d_ws;
    constexpr int NPH = 11;
    if (MK_N_LAUNCHES == 1) {
        a.ph_lo = 0; a.ph_hi = NPH;
        void* args[] = {&a};
        hipError_t e = hipLaunchCooperativeKernel((const void*)yoco_fwd, dim3(grid), dim3(NTHR), args, LDS_BYTES, stream);
        if (e != hipSuccess) fprintf(stderr, "cooperative launch failed: %s (grid %d)\n", hipGetErrorString(e), grid);
    } else {
        for (int ph = 0; ph < NPH; ++ph) {
            a.ph_lo = ph; a.ph_hi = ph + 1;
            void* args[] = {&a};
            hipError_t e = hipLaunchCooperativeKernel((const void*)yoco_fwd, dim3(grid), dim3(NTHR), args, LDS_BYTES, stream);
            if (e != hipSuccess) { fprintf(stderr, "cooperative launch %d failed: %s (grid %d)\n", ph, hipGetErrorString(e), grid); break; }
        }
    }
}
```

```cpp
#include <hip/hip_runtime.h>
#include <hip/hip_cooperative_groups.h>
#include <cstdio>
#include <cstdint>
namespace cg = cooperative_groups;

#define TIDX_LDS_OFF 146944
extern __shared__ __attribute__((aligned(16))) unsigned char lds_raw_[];
__device__ __forceinline__ int tidx() {
    const unsigned key = (unsigned)__builtin_amdgcn_s_getreg((5 << 11) | 4) & 63u;
    const int wv = __builtin_amdgcn_readfirstlane(((volatile const int*)(lds_raw_ + TIDX_LDS_OFF))[key]);
    return wv * 64 + (int)__builtin_amdgcn_mbcnt_hi(~0u, __builtin_amdgcn_mbcnt_lo(~0u, 0u));
}
namespace pg8 {
#define PG8_LAS __attribute__((address_space(3)))
typedef unsigned short bf16_t;
typedef short bf16x8 __attribute__((ext_vector_type(8)));
typedef float f32x4 __attribute__((ext_vector_type(4)));
typedef unsigned u32x4 __attribute__((ext_vector_type(4)));
constexpr int BM = 256, BK = 64, HALF = 128, HTB = HALF * BK * 2  , STAGE_BYTES = 8 * HTB, NXCD = 8, WGM = 8;

__host__ __device__ __forceinline__ int lds_byte(int r, int c) { const int st = (r >> 4) * 2 + (c >> 5), rr = r & 15, cc = c & 31, ob = rr * 64 + cc * 2; return st * 1024 + (ob ^ (((ob >> 9) & 1) << 5)); }
__host__ __device__ __forceinline__ void stage_rc(int b, int& R, int& C) { const int st = b / 1024, sb = b % 1024, swz = sb ^ (((sb >> 9) & 1) << 5); R = (st >> 1) * 16 + swz / 64; C = (st & 1) * 32 + (swz % 64) / 2; }
__host__ __device__ __forceinline__ int perm32(int rho) { const int n = rho >> 4, i = rho & 15; return 8 * (i >> 2) + 4 * n + (i & 3); }

struct Unit { int pm, pn; };
struct Gemm { const bf16_t* A; const bf16_t* Bt; int M, N, K; };

struct StaticOrder {
    int nM, nN, nwg, G, c;
    __host__ __device__ void init(int M, int N, int G_, int c_) { nM = M / BM; nN = N / BM; nwg = nM * nN; G = G_; c = c_; }
    __host__ __device__ bool next(int i, Unit& u) const {
        const long L = (long)i * G + c; if (L >= nwg) return false;
        int wgid = (int)L; { const int q = nwg / NXCD, r = nwg % NXCD, xcd = wgid % NXCD, off = wgid / NXCD; wgid = (xcd < r ? xcd * (q + 1) : r * (q + 1) + (xcd - r) * q) + off; }
        const int nig = WGM * nN, gid = wgid / nig, fm = gid * WGM, gsz = (nM - fm) < WGM ? (nM - fm) : WGM;
        u.pm = fm + ((wgid % nig) % gsz); u.pn = (wgid % nig) / gsz; return true;
    }
    __device__ __forceinline__ void a_ready(const Unit&) const {}
    __device__ __forceinline__ void done(const Unit&) const {}
};


typedef float f32x2_t __attribute__((ext_vector_type(2))); typedef __bf16 bf16x2_t __attribute__((ext_vector_type(2)));
typedef unsigned u32x2 __attribute__((ext_vector_type(2)));
__device__ __forceinline__ unsigned cvt_pk_bf16(float lo, float hi) { unsigned r; asm volatile("v_cvt_pk_bf16_f32 %0, %1, %2" : "=v"(r) : "v"(lo), "v"(hi)); return r; }
__device__ __forceinline__ unsigned pk2(float lo, float hi) { f32x2_t v = {lo, hi}; bf16x2_t b = __builtin_convertvector(v, bf16x2_t); return __builtin_bit_cast(unsigned, b); }

struct EpiProj {
    static constexpr bool PERM = true, AFTER_DRAIN = false;
    bf16_t* MI; bf16_t* MQ; bf16_t* KB; bf16_t* VB; float* kout; float* vout; float smi, smq; const PG8_LAS float* rs;
    __device__ __forceinline__ void operator()(const f32x4 (&acc)[2][2][4][2], const Unit& u, int wr, int wc, int fr, int fq) const {
        const int row0 = u.pm * BM + wr * 64 + fr; const int sec = u.pn >> 1; const int colt = (u.pn & 1) * 256 + wc * 32 + 8 * fq;
        bf16_t* bdst = sec == 0 ? MI : sec == 1 ? MQ : sec == 2 ? KB : VB; float* fdst = sec == 2 ? kout : sec == 3 ? vout : nullptr; const float sc = sec == 0 ? smi : sec == 1 ? smq : 1.f;
#pragma unroll
        for (int ai = 0; ai < 2; ++ai)
#pragma unroll
            for (int m = 0; m < 4; ++m) { const size_t ro = (size_t)(row0 + ai * HALF + m * 16) * 512 + colt; const float scr = rs ? sc * rs[ai * HALF + wr * 64 + m * 16 + fr] : sc;
#pragma unroll
                for (int bj = 0; bj < 2; ++bj) { const f32x4 v0 = acc[ai][bj][m][0] * scr, v1 = acc[ai][bj][m][1] * scr;
                    u32x4 w; w.x = cvt_pk_bf16(v0[0], v0[1]); w.y = cvt_pk_bf16(v0[2], v0[3]); w.z = cvt_pk_bf16(v1[0], v1[1]); w.w = cvt_pk_bf16(v1[2], v1[3]);
                    *(u32x4*)(bdst + ro + bj * HALF) = w;
                    if (fdst) { __builtin_nontemporal_store(v0, (f32x4*)(fdst + ro + bj * HALF)); __builtin_nontemporal_store(v1, (f32x4*)(fdst + ro + bj * HALF + 4)); } } }
    }
};
struct EpiUp {
    static constexpr bool PERM = true, AFTER_DRAIN = false;
    bf16_t* O; int ldc; const PG8_LAS float* rs;
    __device__ __forceinline__ void operator()(const f32x4 (&acc)[2][2][4][2], const Unit& u, int wr, int wc, int fr, int fq) const {
        const int row0 = u.pm * BM + wr * 64 + fr; const int col0 = u.pn * BM + wc * 32 + 8 * fq;
#pragma unroll
        for (int ai = 0; ai < 2; ++ai)
#pragma unroll
            for (int m = 0; m < 4; ++m) { bf16_t* rowp = O + (size_t)(row0 + ai * HALF + m * 16) * ldc + col0; const float rr = rs[ai * HALF + wr * 64 + m * 16 + fr];
#pragma unroll
                for (int bj = 0; bj < 2; ++bj) { f32x4 v0 = acc[ai][bj][m][0], v1 = acc[ai][bj][m][1];
#pragma unroll
                    for (int i = 0; i < 4; ++i) { const float a = (v0[i] > 0.f ? v0[i] : 0.f) * rr, b = (v1[i] > 0.f ? v1[i] : 0.f) * rr; v0[i] = a * a; v1[i] = b * b; }
                    u32x4 w; w.x = cvt_pk_bf16(v0[0], v0[1]); w.y = cvt_pk_bf16(v0[2], v0[3]); w.z = cvt_pk_bf16(v1[0], v1[1]); w.w = cvt_pk_bf16(v1[2], v1[3]);
                    *(u32x4*)(rowp + bj * HALF) = w; } }
    }
};
template <bool BASE_F32, bool FINAL>
struct EpiNorm {
    static constexpr bool PERM = true, AFTER_DRAIN = true;
    const void* base; float* out; bf16_t* xb; float* ssq; const float* gain; float* slots1; unsigned* cnt1;
    __device__ __forceinline__ void stats(const f32x4 (&v)[2][2][4][2], const Unit& u, int wr, int wc, int fr, int fq, PG8_LAS unsigned char* lds, int wid, int lane, float* slots, unsigned* cnt) const {
        PG8_LAS float* P = (PG8_LAS float*)lds;
        PG8_LAS float* S = (PG8_LAS float*)(lds + 4096);
#pragma unroll
        for (int ai = 0; ai < 2; ++ai)
#pragma unroll
            for (int m = 0; m < 4; ++m) {
                float s = 0.f;
#pragma unroll
                for (int bj = 0; bj < 2; ++bj)
#pragma unroll
                    for (int n = 0; n < 2; ++n) { const f32x4 x = v[ai][bj][m][n]; s += (x[0] * x[0] + x[1] * x[1]) + (x[2] * x[2] + x[3] * x[3]); }
                s += __shfl_xor(s, 16); s += __shfl_xor(s, 32);
                if (fq == 0) P[(ai * HALF + wr * 64 + m * 16 + fr) * 4 + wc] = s;
            }
        asm volatile("s_waitcnt lgkmcnt(0)" ::: "memory"); __builtin_amdgcn_s_barrier(); asm volatile("" ::: "memory");
        const int row = wid * 32 + (lane & 31);
        if (lane < 32) {
            const float s = (P[row * 4 + 0] + P[row * 4 + 1]) + (P[row * 4 + 2] + P[row * 4 + 3]);
            __hip_atomic_store(slots + ((size_t)(u.pm * BM + row) * 4 + u.pn), s, __ATOMIC_RELAXED, __HIP_MEMORY_SCOPE_AGENT);
        }
        asm volatile("s_waitcnt vmcnt(0)" ::: "memory");
        if (lane == 0) __hip_atomic_fetch_add(cnt + 64 * u.pm, 1u, __ATOMIC_RELAXED, __HIP_MEMORY_SCOPE_AGENT);
        if (wid == 0) {
            unsigned spins = 0;
            for (;;) {
                if ((unsigned)__builtin_amdgcn_readfirstlane(__hip_atomic_load(cnt + 64 * u.pm, __ATOMIC_RELAXED, __HIP_MEMORY_SCOPE_AGENT)) >= 32u) break;
                if (++spins > (1u << 22)) break;
                __builtin_amdgcn_s_sleep(2);
            }
            __builtin_amdgcn_fence(__ATOMIC_ACQUIRE, "agent");
        }
        asm volatile("s_waitcnt vmcnt(0) lgkmcnt(0)" ::: "memory"); __builtin_amdgcn_s_barrier(); asm volatile("" ::: "memory");
        if (lane < 32) {
            const float* sl = slots + (size_t)(u.pm * BM + row) * 4; float t = 0.f;
#pragma unroll
            for (int q = 0; q < 4; ++q) t += __hip_atomic_load(sl + q, __ATOMIC_RELAXED, __HIP_MEMORY_SCOPE_AGENT);
            S[row] = 1.0f / sqrtf(t * (1.0f / 1024.0f) + 1e-6f);
        }
        asm volatile("s_waitcnt vmcnt(0) lgkmcnt(0)" ::: "memory"); __builtin_amdgcn_s_barrier(); asm volatile("" ::: "memory");
    }
    __device__ __forceinline__ void fused(f32x4 (&acc)[2][2][4][2], const Unit& u, int wr, int wc, int fr, int fq, PG8_LAS unsigned char* lds, int wid, int lane) const {
        const PG8_LAS float* S = (const PG8_LAS float*)(lds + 4096);
        const int col0 = u.pn * BM + wc * 32 + 8 * fq;
        stats(acc, u, wr, wc, fr, fq, lds, wid, lane, slots1, cnt1);
        f32x4 gv[2][2];
#pragma unroll
        for (int bj = 0; bj < 2; ++bj)
#pragma unroll
            for (int n = 0; n < 2; ++n) gv[bj][n] = *(const f32x4*)(gain + col0 + bj * HALF + n * 4);
#pragma unroll
        for (int ai = 0; ai < 2; ++ai)
#pragma unroll
            for (int m = 0; m < 4; ++m) { const int r = ai * HALF + wr * 64 + m * 16 + fr; const float rs = S[r]; const size_t off = (size_t)(u.pm * BM + r) * 1024 + col0;
                float sq = 0.f;
#pragma unroll
                for (int bj = 0; bj < 2; ++bj) { f32x4 b0, b1;
                    if (BASE_F32) { b0 = __builtin_nontemporal_load((const f32x4*)((const float*)base + off + bj * HALF)); b1 = __builtin_nontemporal_load((const f32x4*)((const float*)base + off + bj * HALF + 4)); }
                    else { const u32x4 bw = __builtin_nontemporal_load((const u32x4*)((const bf16_t*)base + off + bj * HALF));
                        b0 = (f32x4){__uint_as_float(bw.x << 16), __uint_as_float(bw.x & 0xffff0000u), __uint_as_float(bw.y << 16), __uint_as_float(bw.y & 0xffff0000u)};
                        b1 = (f32x4){__uint_as_float(bw.z << 16), __uint_as_float(bw.z & 0xffff0000u), __uint_as_float(bw.w << 16), __uint_as_float(bw.w & 0xffff0000u)}; }
                    const f32x4 x0 = b0 + acc[ai][bj][m][0] * gv[bj][0] * rs, x1 = b1 + acc[ai][bj][m][1] * gv[bj][1] * rs;
                    if (FINAL) { __builtin_nontemporal_store(x0, (f32x4*)(out + off + bj * HALF)); __builtin_nontemporal_store(x1, (f32x4*)(out + off + bj * HALF + 4)); }
                    else { sq += ((x0[0] * x0[0] + x0[1] * x0[1]) + (x0[2] * x0[2] + x0[3] * x0[3])) + ((x1[0] * x1[0] + x1[1] * x1[1]) + (x1[2] * x1[2] + x1[3] * x1[3]));
                        u32x4 w; w.x = cvt_pk_bf16(x0[0], x0[1]); w.y = cvt_pk_bf16(x0[2], x0[3]); w.z = cvt_pk_bf16(x1[0], x1[1]); w.w = cvt_pk_bf16(x1[2], x1[3]); *(u32x4*)(xb + off + bj * HALF) = w; } }
                if (!FINAL) { sq += __shfl_xor(sq, 16); sq += __shfl_xor(sq, 32); if (fq == 0) ssq[(size_t)(u.pm * BM + r) * 16 + u.pn * 4 + wc] = sq; }
                if ((m & 3) == 3) asm volatile("" ::: "memory"); }
    }
};

template <class Epi, class Sched, bool ALIGN_EPI = false, bool SP2 = false>
__device__ __forceinline__ void gemm_phase(PG8_LAS unsigned char* lds, const Gemm g, const Sched& S, const Epi& E) {
    const int tid = tidx(), wid = __builtin_amdgcn_readfirstlane(tid >> 6), lane = tid & 63, wr = wid >> 2, wc = wid & 3, fr = lane & 15, fq = lane >> 4;
    const int K = g.K, nt = K / BK;
    unsigned voffA[2], voffB[2];
#pragma unroll
    for (int i = 0; i < 2; ++i) { int R, C; stage_rc(tid * 16 + i * 8192, R, C); const int Rb = Epi::PERM ? ((R & ~31) + perm32(R & 31)) : R;
        voffA[i] = (unsigned)(R * K + C) * 2u; voffB[i] = (unsigned)(Rb * K + C) * 2u; }
    const size_t kstep = (size_t)(BK * 2);
    const size_t hstep = (size_t)HALF * K * 2;
    const size_t tstep = 2 * hstep;
    const unsigned ldsw = (unsigned)wid * 1024u;
    const int aoff = lds_byte(wr * 64 + fr, fq * 8), boff = lds_byte(wc * 32 + fr, fq * 8);
#define PG8_SA(b, h) (((b) * 2 + (h)) * HTB)
#define PG8_SB(b, h) ((4 + (b) * 2 + (h)) * HTB)
#define PG8_STAGE(bufoff, gbase, voff) do { _Pragma("unroll") for (int _i = 0; _i < 2; ++_i) \
        __builtin_amdgcn_global_load_lds((const unsigned*)((const char*)(gbase) + (voff)[_i]), (PG8_LAS unsigned*)(lds + (bufoff) + ldsw + _i * 8192), 16, 0, 0); } while (0)
#define PG8_LDA(dst, b, h) do { _Pragma("unroll") for (int m = 0; m < 4; ++m) _Pragma("unroll") for (int k = 0; k < 2; ++k) dst[m][k] = *(const PG8_LAS bf16x8*)(lds + PG8_SA(b, h) + aoff + m * 2048 + k * 1024); } while (0)
#define PG8_LDB(dst, b, h) do { _Pragma("unroll") for (int n = 0; n < 2; ++n) _Pragma("unroll") for (int k = 0; k < 2; ++k) dst[n][k] = *(const PG8_LAS bf16x8*)(lds + PG8_SB(b, h) + boff + n * 2048 + k * 1024); } while (0)
#define PG8_MMA(ai, bj, At, Bt) do { __builtin_amdgcn_s_setprio(1); _Pragma("unroll") for (int m = 0; m < 4; ++m) _Pragma("unroll") for (int n = 0; n < 2; ++n) _Pragma("unroll") for (int k = 0; k < 2; ++k) \
        acc[ai][bj][m][n] = __builtin_amdgcn_mfma_f32_16x16x32_bf16(Bt[n][k], At[m][k], acc[ai][bj][m][n], 0, 0, 0); __builtin_amdgcn_s_setprio(0); } while (0)
#define PG8_WAIT_V(n) asm volatile("s_waitcnt vmcnt(" #n ")" ::: "memory")
#define PG8_WAIT_L(n) asm volatile("s_waitcnt lgkmcnt(" #n ")" ::: "memory")
#define PG8_BAR __builtin_amdgcn_s_barrier()
#define PG8_SCHED __builtin_amdgcn_sched_barrier(0)
    Unit cur, nxt; int ui = 0;
    if (!S.next(0, cur)) return;
    f32x4 acc[2][2][4][2];
#pragma unroll
    for (int a = 0; a < 2; ++a)
#pragma unroll
        for (int b = 0; b < 2; ++b)
#pragma unroll
            for (int m = 0; m < 4; ++m)
#pragma unroll
                for (int n = 0; n < 2; ++n) acc[a][b][m][n] = (f32x4){0.f, 0.f, 0.f, 0.f};
    bf16x8 At[4][2], B0[2][2], B1[2][2];
    const char* cA = (const char*)g.A + (size_t)cur.pm * tstep; const char* cB = (const char*)g.Bt + (size_t)cur.pn * tstep;
    S.a_ready(cur);
    if constexpr (SP2) {
        PG8_STAGE(PG8_SB(0, 0), cB, voffB); PG8_STAGE(PG8_SB(0, 1), cB + hstep, voffB); PG8_STAGE(PG8_SA(0, 0), cA, voffA); PG8_STAGE(PG8_SA(0, 1), cA + hstep, voffA);
        if (wr == 1) PG8_BAR;
        PG8_WAIT_V(2); PG8_BAR;
        PG8_STAGE(PG8_SB(1, 0), cB + kstep, voffB); PG8_STAGE(PG8_SA(1, 0), cA + kstep, voffA); PG8_STAGE(PG8_SB(1, 1), cB + hstep + kstep, voffB);
        PG8_WAIT_V(6); PG8_BAR;
    } else {
        PG8_STAGE(PG8_SB(0, 0), cB, voffB); PG8_STAGE(PG8_SA(0, 0), cA, voffA); PG8_STAGE(PG8_SB(0, 1), cB + hstep, voffB); PG8_STAGE(PG8_SA(0, 1), cA + hstep, voffA);
        if (wr == 1) PG8_BAR;
        PG8_WAIT_V(4); PG8_BAR;
        PG8_STAGE(PG8_SB(1, 0), cB + kstep, voffB); PG8_STAGE(PG8_SA(1, 0), cA + kstep, voffA); PG8_STAGE(PG8_SB(1, 1), cB + hstep + kstep, voffB);
        PG8_WAIT_V(6); PG8_BAR;
    }
    for (;;) {
        const bool has_next = S.next(ui + 1, nxt);
        const char* nA = has_next ? (const char*)g.A + (size_t)nxt.pm * tstep : cA; const char* nB = has_next ? (const char*)g.Bt + (size_t)nxt.pn * tstep : cB;
        for (int t = 0; t < nt; t += 2) {
            const bool last = (t == nt - 2);
            const char* a1 = cA + (size_t)(t + 1) * kstep;
            const char* a2 = last ? nA : cA + (size_t)(t + 2) * kstep; const char* b2 = last ? nB : cB + (size_t)(t + 2) * kstep;
            const char* a3 = a2 + kstep; const char* b3 = b2 + kstep;
            if (last && has_next) S.a_ready(nxt);
            if constexpr (SP2) {
            PG8_LDB(B0, 0, 0); PG8_LDB(B1, 0, 1); PG8_SCHED; PG8_LDA(At, 0, 0); PG8_STAGE(PG8_SA(1, 1), a1 + hstep, voffA);
            PG8_WAIT_V(8); PG8_WAIT_L(0); PG8_BAR; PG8_MMA(0, 0, At, B0); PG8_MMA(0, 1, At, B1); PG8_BAR; PG8_SCHED;
            PG8_LDA(At, 0, 1); PG8_STAGE(PG8_SB(0, 0), b2, voffB); PG8_STAGE(PG8_SB(0, 1), b2 + hstep, voffB); PG8_STAGE(PG8_SA(0, 0), a2, voffA);
            PG8_WAIT_V(8); PG8_WAIT_L(0); PG8_BAR; PG8_MMA(1, 0, At, B0); PG8_MMA(1, 1, At, B1); PG8_BAR; PG8_SCHED;
            PG8_LDB(B0, 1, 0); PG8_LDB(B1, 1, 1); PG8_SCHED; PG8_LDA(At, 1, 0); PG8_STAGE(PG8_SA(0, 1), a2 + hstep, voffA);
            PG8_WAIT_V(8); PG8_WAIT_L(0); PG8_BAR; PG8_MMA(0, 0, At, B0); PG8_MMA(0, 1, At, B1); PG8_BAR; PG8_SCHED;
            PG8_LDA(At, 1, 1); PG8_STAGE(PG8_SB(1, 0), b3, voffB); PG8_STAGE(PG8_SB(1, 1), b3 + hstep, voffB); PG8_STAGE(PG8_SA(1, 0), a3, voffA);
            PG8_WAIT_V(8); PG8_WAIT_L(0); PG8_BAR; PG8_MMA(1, 0, At, B0); PG8_MMA(1, 1, At, B1); PG8_BAR; PG8_SCHED;
            } else {
            PG8_LDB(B0, 0, 0); PG8_SCHED; PG8_LDA(At, 0, 0); PG8_STAGE(PG8_SA(1, 1), a1 + hstep, voffA);
            PG8_WAIT_L(8); PG8_BAR; PG8_WAIT_L(0); PG8_MMA(0, 0, At, B0); PG8_BAR; PG8_SCHED;
            PG8_LDB(B1, 0, 1); PG8_STAGE(PG8_SB(0, 0), b2, voffB);
            PG8_BAR; PG8_WAIT_L(0); PG8_MMA(0, 1, At, B1); PG8_BAR;
            PG8_LDA(At, 0, 1); PG8_STAGE(PG8_SA(0, 0), a2, voffA);
            PG8_BAR; PG8_WAIT_L(0); PG8_MMA(1, 0, At, B0); PG8_BAR; PG8_SCHED;
            PG8_STAGE(PG8_SB(0, 1), b2 + hstep, voffB);
            PG8_WAIT_V(6); PG8_BAR; PG8_MMA(1, 1, At, B1); PG8_BAR;
            PG8_LDB(B0, 1, 0); PG8_SCHED; PG8_LDA(At, 1, 0); PG8_STAGE(PG8_SA(0, 1), a2 + hstep, voffA);
            PG8_WAIT_L(8); PG8_BAR; PG8_WAIT_L(0); PG8_MMA(0, 0, At, B0); PG8_BAR; PG8_SCHED;
            PG8_LDB(B1, 1, 1); PG8_STAGE(PG8_SB(1, 0), b3, voffB);
            PG8_BAR; PG8_WAIT_L(0); PG8_MMA(0, 1, At, B1); PG8_BAR;
            PG8_LDA(At, 1, 1); PG8_STAGE(PG8_SA(1, 0), a3, voffA);
            PG8_BAR; PG8_WAIT_L(0); PG8_MMA(1, 0, At, B0); PG8_BAR; PG8_SCHED;
            PG8_STAGE(PG8_SB(1, 1), b3 + hstep, voffB);
            PG8_WAIT_V(6); PG8_BAR; PG8_MMA(1, 1, At, B1); PG8_BAR;
            }
        }
        if constexpr (ALIGN_EPI) { if (wr == 0) PG8_BAR; }
        if constexpr (!Epi::AFTER_DRAIN) { E(acc, cur, wr, wc, fr, fq); S.done(cur); }
        if (!has_next) break;
#pragma unroll
        for (int a = 0; a < 2; ++a)
#pragma unroll
            for (int b = 0; b < 2; ++b)
#pragma unroll
                for (int m = 0; m < 4; ++m)
#pragma unroll
                    for (int n = 0; n < 2; ++n) acc[a][b][m][n] = (f32x4){0.f, 0.f, 0.f, 0.f};
        cur = nxt; cA = nA; cB = nB; ++ui;
        if constexpr (ALIGN_EPI) { if (wr == 1) PG8_BAR; }
    }
    PG8_WAIT_V(0);
    if constexpr (!ALIGN_EPI) { if (wr == 0) PG8_BAR; }
    PG8_BAR;
    if constexpr (Epi::AFTER_DRAIN) { E.fused(acc, cur, wr, wc, fr, fq, lds, wid, lane); S.done(cur); }
#undef PG8_SA
#undef PG8_SB
#undef PG8_STAGE
#undef PG8_LDA
#undef PG8_LDB
#undef PG8_MMA
#undef PG8_WAIT_V
#undef PG8_WAIT_L
#undef PG8_BAR
#undef PG8_SCHED
}
}

using pg8::bf16_t; using pg8::bf16x8; using pg8::f32x4; using pg8::u32x4; using pg8::u32x2; using pg8::pk2;
typedef float f32x16 __attribute__((ext_vector_type(16)));
typedef float f32x2v __attribute__((ext_vector_type(2)));
typedef short s16x4v __attribute__((ext_vector_type(4)));
#define LAS3 __attribute__((address_space(3)))
typedef short s16x8 __attribute__((ext_vector_type(8)));
constexpr int DM = 1024, MP = 16384, MS = 128, MT = MP + MS, SEQ = 4096, NB = 4, DB = 8, DS = 16, PAST = 2048, LKS = 2112  , NKS = 64  , FF = 4096, NMEM = 256;
constexpr float LOG2E = 1.4426950408889634f;
constexpr float CFOX = 0.125f * LOG2E, CMEM = 0.08838834764831845f * LOG2E;
constexpr int NTHR = 512;
constexpr int LDS_BYTES = 147456, RING_BYTES = 131072, MISC_OFF = LDS_BYTES - 256;

constexpr size_t O_Y = 0, O_YS = 16777216, O_PSP = 16908288, O_PSS = 16939008, O_KP = 17000448, O_VP = 25389056, O_LFP = 33777664, O_KS = 33908736, O_VS = 33974272, O_LFS = 34039808, O_MK = 34040832, O_MV = 35089408;

constexpr size_t MiB = 1u << 20;
constexpr size_t WS_CTL = 0, CTL_BYTES = 1 * MiB;
constexpr size_t WS_SLOTS = 1 * MiB;
constexpr size_t SLOT_BANK = 69632;
constexpr size_t WS_WIN0 = 4 * MiB;
constexpr size_t WS_WINKV = 6 * MiB;
constexpr size_t WS_WOUT = 10 * MiB;
constexpr size_t WS_WUP = 14 * MiB;
constexpr size_t WS_WDN = 30 * MiB;
constexpr size_t WS_WMEM = 46 * MiB;
constexpr size_t WS_WPOOL = 50 * MiB;
constexpr size_t WS_WF = 50 * MiB + 512 * 1024;
constexpr size_t WS_MN = 51 * MiB;
constexpr size_t WS_MKVP = 53 * MiB;
constexpr size_t WS_MKS = 57 * MiB;
constexpr size_t WS_MVS = 61 * MiB;
constexpr size_t WS_XN = 65 * MiB;
constexpr size_t WS_OV = 100 * MiB;
constexpr size_t WS_HB = WS_OV;
constexpr size_t WS_MI = WS_OV;
constexpr size_t WS_MQ = WS_OV + 17 * MiB;
constexpr size_t WS_CAT = WS_OV + 34 * MiB;
constexpr size_t WS_KB = WS_OV + 67 * MiB;
constexpr size_t WS_VB = WS_OV + 84 * MiB;
constexpr size_t WS_KSB = WS_OV + 101 * MiB;
constexpr size_t WS_VSB = WS_OV + 118 * MiB;
constexpr size_t WS_SSQ = WS_OV + 135 * MiB;
constexpr size_t WS_END = WS_SSQ + 2 * MiB;
static_assert((size_t)MT * FF * 2 <= 135 * MiB, "HB fits");
constexpr int CW_Q = 64;
constexpr int CW_CNT = 1024;
constexpr int CW_BAR = 65536;

struct Params { const float* in[24]; float* out; unsigned char* ws; int ph_lo, ph_hi; };

#define MFMA32(a, b, c) __builtin_amdgcn_mfma_f32_32x32x16_bf16((a), (b), (c), 0, 0, 0)
__device__ __forceinline__ int crow(int r, int h) { return (r & 3) + 8 * (r >> 2) + 4 * h; }
__device__ __forceinline__ float bf2f(unsigned short u) { return __uint_as_float((unsigned)u << 16); }
__device__ __forceinline__ unsigned short f2bf(float f) { return (unsigned short)(pk2(f, 0.f) & 0xffffu); }
__device__ __forceinline__ size_t foff(int row, int k, int K) { return ((((size_t)(row >> 5) * (K >> 4) + (k >> 4)) * 64 + ((k >> 3) & 1) * 32 + (row & 31)) << 3) + (k & 7); }
__device__ __forceinline__ float wave_sum(float v) {
#pragma unroll
    for (int o = 1; o < 64; o <<= 1) v += __shfl_xor(v, o);
    return v;
}

__device__ __forceinline__ void transpose_item(const float* W, int K, int N, int ldw, const float* gain, bf16_t* WT, float* scr, int item, int lane) {
    const int nblk = N / 64, kb = item / nblk, nb = item % nblk, k0 = 64 * kb, n0 = 64 * nb;
    const int lr = lane >> 4, lc = 4 * (lane & 15);
    f32x4 v[16];
#pragma unroll
    for (int i = 0; i < 16; ++i) v[i] = __builtin_nontemporal_load((const f32x4*)(W + (size_t)(k0 + 4 * i + lr) * ldw + n0 + lc));
#pragma unroll
    for (int i = 0; i < 16; ++i) { const int kk = 4 * i + lr; const float gk = gain ? gain[k0 + kk] : 1.f; float* d = scr + kk * 65 + lc; d[0] = v[i].x * gk; d[1] = v[i].y * gk; d[2] = v[i].z * gk; d[3] = v[i].w * gk; }
    asm volatile("s_waitcnt lgkmcnt(0)" ::: "memory");
    const int c = lane & 7;
#pragma unroll
    for (int j = 0; j < 8; ++j) { const int n = (lane >> 3) + 8 * j; const float* s = scr + (8 * c) * 65 + n;
        u32x4 o; o.x = pk2(s[0 * 65], s[1 * 65]); o.y = pk2(s[2 * 65], s[3 * 65]); o.z = pk2(s[4 * 65], s[5 * 65]); o.w = pk2(s[6 * 65], s[7 * 65]);
        *(u32x4*)(WT + (size_t)(n0 + n) * K + k0 + 8 * c) = o; }
    asm volatile("s_waitcnt lgkmcnt(0)" ::: "memory");
}
__device__ __forceinline__ void norm_row_to_bf16(const float* xrow, bf16_t* orow, int lane, int frow = -1) {
    const f32x4* xr = (const f32x4*)xrow + lane;
    f32x4 v[4]; float s = 0.f;
#pragma unroll
    for (int j = 0; j < 4; ++j) { v[j] = __builtin_nontemporal_load(xr + 64 * j); s += (v[j].x * v[j].x + v[j].y * v[j].y) + (v[j].z * v[j].z + v[j].w * v[j].w); }
    const float rs = 1.f / sqrtf(wave_sum(s) * (1.f / 1024.f) + 1e-6f);
    u32x2* o8 = (u32x2*)orow + lane;
#pragma unroll
    for (int j = 0; j < 4; ++j) { u32x2 w; w.x = pk2(v[j].x * rs, v[j].y * rs); w.y = pk2(v[j].z * rs, v[j].w * rs);
        if (frow < 0) o8[64 * j] = w; else *(u32x2*)(orow + foff(frow, 256 * j + 4 * lane, 1024)) = w; }
}
__device__ __forceinline__ void cvt_rows(const float* src, bf16_t* dst, size_t nchunks  , int chunks_per_row, int rpb, int dpb, size_t gtid, size_t gn) {
    for (size_t c = gtid; c < nchunks; c += gn) {
        const size_t r = c / chunks_per_row; const int cc = (int)(c % chunks_per_row);
        const size_t dr = (r / rpb) * dpb + (r % rpb);
        const f32x4 a = __builtin_nontemporal_load((const f32x4*)(src + c * 8)), b = __builtin_nontemporal_load((const f32x4*)(src + c * 8 + 4));
        u32x4 w; w.x = pk2(a.x, a.y); w.y = pk2(a.z, a.w); w.z = pk2(b.x, b.y); w.w = pk2(b.z, b.w);
        *(u32x4*)(dst + (dr * chunks_per_row + cc) * 8) = w;
    }
}

template <bool AFRAG = true>
__device__ __forceinline__ void skinny_gemm(const bf16_t* A, const bf16_t* Bt, int K_, int row0, int col0, float* red, f32x4 (&o)[2]) {
    const int tid = tidx(), w = tid >> 6, lane = tid & 63, r32 = lane & 31, h = lane >> 5, kg = w & 3, rh = w >> 2;
    int K = K_; asm volatile("" : "+s"(K));
    const int nch = K >> 10;
    unsigned char* Bs = (unsigned char*)red;
    const bf16x8* ap = (const bf16x8*)A + ((size_t)((row0 >> 5) + 2 * rh) * (K >> 4) + 16 * kg) * 64 + lane;
    const size_t rbs = (size_t)(K >> 4) * 64;
    const bf16_t* apr = A + (size_t)(row0 + 64 * rh + r32) * K + 256 * kg + 8 * h;
    f32x16 acc[2];
#pragma unroll
    for (int i = 0; i < 2; ++i)
#pragma unroll
        for (int r = 0; r < 16; ++r) acc[i][r] = 0.f;
    u32x4 br[8];
#define SK_BLOAD(ch) do { _Pragma("unroll") for (int i_ = 0; i_ < 8; ++i_) { const int idx_ = tid + NTHR * i_; br[i_] = *(const u32x4*)(Bt + (size_t)(col0 + (idx_ >> 7)) * K + (ch) * 1024 + (idx_ & 127) * 8); } } while (0)
#define SK_ALOAD(dst, ch, hf) do { _Pragma("unroll") for (int ks_ = 0; ks_ < 8; ++ks_) _Pragma("unroll") for (int rb_ = 0; rb_ < 2; ++rb_) \
        dst[ks_][rb_] = AFRAG ? ap[rb_ * rbs + (size_t)((ch) * 64 + (hf) * 8 + ks_) * 64] : *(const bf16x8*)(apr + (size_t)rb_ * 32 * K + (ch) * 1024 + (hf) * 128 + 16 * ks_); } while (0)
#define SK_COMP(src, hf) do { _Pragma("unroll") for (int ks_ = 0; ks_ < 8; ++ks_) { const bf16x8 b_ = *(const bf16x8*)(Bs + r32 * 2064 + (256 * kg + (hf) * 128 + 16 * ks_ + 8 * h) * 2); \
        _Pragma("unroll") for (int rb_ = 0; rb_ < 2; ++rb_) acc[rb_] = MFMA32(b_, src[ks_][rb_], acc[rb_]); } } while (0)
    bf16x8 a0[8][2];
    SK_BLOAD(0);
#pragma nounroll
    for (int ch = 0; ch < nch; ++ch) {
        SK_ALOAD(a0, ch, 0);
        __syncthreads();
#pragma unroll
        for (int i = 0; i < 8; ++i) { const int idx = tid + NTHR * i; *(u32x4*)(Bs + (idx >> 7) * 2064 + (idx & 127) * 16) = br[i]; }
        __syncthreads();
        if (ch + 1 < nch) SK_BLOAD(ch + 1);
        SK_COMP(a0, 0);
        SK_ALOAD(a0, ch, 1);
        SK_COMP(a0, 1);
    }
#undef SK_BLOAD
#undef SK_ALOAD
#undef SK_COMP
    __syncthreads();
#pragma unroll
    for (int rb = 0; rb < 2; ++rb)
#pragma unroll
        for (int r = 0; r < 16; ++r) red[((kg * 4 + 2 * rh + rb) * 16 + r) * 64 + lane] = acc[rb][r];
    __syncthreads();
    const int rbo = w >> 1, rbase = 8 * (w & 1);
    float v[8];
#pragma unroll
    for (int i = 0; i < 8; ++i) { float s = 0.f;
#pragma unroll
        for (int q = 0; q < 4; ++q) s += red[((q * 4 + rbo) * 16 + rbase + i) * 64 + lane];
        v[i] = s; }
    o[0] = (f32x4){v[0], v[1], v[2], v[3]}; o[1] = (f32x4){v[4], v[5], v[6], v[7]};
    __syncthreads();
}
__device__ __forceinline__ void skinny_rowsum(float s, float* tmp  , float* part  ) {
    const int tid = tidx(), w = tid >> 6, lane = tid & 63, r32 = lane & 31, h = lane >> 5;
    s += __shfl_xor(s, 32);
    if (h == 0) tmp[(w & 1) * 128 + 32 * (w >> 1) + r32] = s;
    __syncthreads();
    if (tid < 128) part[tid] = tmp[tid] + tmp[128 + tid];
    __syncthreads();
}
__device__ __forceinline__ void row_exchange(float* slots  , unsigned* cnt, int nparts, int part, int rows, const float* partL, float* totL) {
    const int tid = tidx(), lane = tid & 63, wid = tid >> 6;
    if (tid < rows) __hip_atomic_store(slots + (size_t)tid * nparts + part, partL[tid], __ATOMIC_RELAXED, __HIP_MEMORY_SCOPE_AGENT);
    asm volatile("s_waitcnt vmcnt(0)" ::: "memory");
    if (lane == 0) __hip_atomic_fetch_add(cnt, 1u, __ATOMIC_RELAXED, __HIP_MEMORY_SCOPE_AGENT);
    if (wid == 0) {
        unsigned spins = 0; const unsigned want = 8u * (unsigned)nparts;
        for (;;) {
            if ((unsigned)__builtin_amdgcn_readfirstlane(__hip_atomic_load(cnt, __ATOMIC_RELAXED, __HIP_MEMORY_SCOPE_AGENT)) >= want) break;
            if (++spins > (1u << 22)) break;
            __builtin_amdgcn_s_sleep(2);
        }
        __builtin_amdgcn_fence(__ATOMIC_ACQUIRE, "agent");
    }
    asm volatile("s_waitcnt vmcnt(0) lgkmcnt(0)" ::: "memory");
    __syncthreads();
    if (tid < rows) { float t = 0.f; for (int q = 0; q < nparts; ++q) t += __hip_atomic_load(slots + (size_t)tid * nparts + q, __ATOMIC_RELAXED, __HIP_MEMORY_SCOPE_AGENT); totL[tid] = t; }
    __syncthreads();
}
__device__ __forceinline__ void skinny_norm(f32x4 (&o)[2], int part, const float* base, float* out, bf16_t* xn, float* ssq_s, const float* gain, float* slots1, unsigned* cnt1, float* ldsf) {
    const int tid = tidx(), w = tid >> 6, lane = tid & 63, r32 = lane & 31, h = lane >> 5;
    float* tmp = ldsf; float* partL = ldsf + 256; float* totL = ldsf + 384;
    const int row = 32 * (w >> 1) + r32; const int c0 = part * 32 + 16 * (w & 1) + 4 * h;
    float s = 0.f;
#pragma unroll
    for (int g = 0; g < 2; ++g) s += (o[g].x * o[g].x + o[g].y * o[g].y) + (o[g].z * o[g].z + o[g].w * o[g].w);
    skinny_rowsum(s, tmp, partL);
    row_exchange(slots1, cnt1, 32, part, 128, partL, totL);
    const float rs1 = 1.0f / sqrtf(totL[row] * (1.0f / 1024.0f) + 1e-6f);
    f32x4 x1[2]; float s2 = 0.f;
#pragma unroll
    for (int g = 0; g < 2; ++g) { const int c = c0 + 8 * g; const f32x4 gv = *(const f32x4*)(gain + c); const f32x4 bs = *(const f32x4*)(base + (size_t)row * 1024 + c); x1[g] = bs + o[g] * gv * rs1;
        s2 += (x1[g].x * x1[g].x + x1[g].y * x1[g].y) + (x1[g].z * x1[g].z + x1[g].w * x1[g].w);
        *(f32x4*)(out + (size_t)row * 1024 + c) = x1[g];
        if (xn) { u32x2 wv; wv.x = pk2(x1[g].x, x1[g].y); wv.y = pk2(x1[g].z, x1[g].w); *(u32x2*)(xn + foff(row, c, 1024)) = wv; } }
    if (xn) { __syncthreads(); skinny_rowsum(s2, tmp, partL); if (tid < 128) ssq_s[tid * 32 + part] = partL[tid]; }
    __syncthreads();
}
__device__ __forceinline__ float sample_rs(const float* ssq_s, int row) {
    const f32x4* q = (const f32x4*)(ssq_s + row * 32); float t = 0.f;
#pragma unroll
    for (int i = 0; i < 8; ++i) { const f32x4 v = q[i]; t += (v.x + v.y) + (v.z + v.w); }
    return 1.0f / sqrtf(t * (1.0f / 1024.0f) + 1e-6f);
}
__device__ __forceinline__ void panel_rs(const float* ssq, int pm, float* rsL) {
    const int tid = tidx();
    if (tid < 256) { const f32x4* q = (const f32x4*)(ssq + (size_t)(pm * 256 + tid) * 16); float t = 0.f;
#pragma unroll
        for (int i = 0; i < 4; ++i) { const f32x4 v = q[i]; t += (v.x + v.y) + (v.z + v.w); }
        rsL[tid] = 1.0f / sqrtf(t * (1.0f / 1024.0f) + 1e-6f); }
    __syncthreads();
}

__device__ __forceinline__ int vpos(int row) { return (row & ~12) | ((row & 4) << 1) | ((row & 8) >> 1); }
__device__ __forceinline__ void fox_bias(float* biasL, float* wsum, const float* s1, int n1, const float* s2, int n, int npad);
template <int HD, bool FOX, bool F32KV = false>
__device__ __forceinline__ void attn_unit(unsigned char* lds, const bf16_t* Q, int ldq, int nq_valid, const bf16_t* Kp, const bf16_t* Vp, int ldk, int n_keys, int qpos0,
                                          const float* biasL, bf16_t* O, int ldo, const float* Kf = nullptr, const float* Vf = nullptr, int nf32 = 0, int frow0 = -1, int fcol0 = 0,
                                          const float* fb_s1 = nullptr, int fb_n1 = 0, const float* fb_s2 = nullptr, int fb_npad = 0, float* fb_wsum = nullptr) {
    constexpr int KT = (HD == 64 && !F32KV) ? 128 : 64, NTT = KT / 32, NKS = KT / 16;
    constexpr int KP = HD * 2 + 16, VP = HD * 2 + 64, KBY = KT * KP, VBY = KT * VP, BUF = KBY + VBY;
    constexpr int CH = HD / 8, NL = (KT * CH) / NTHR, ND = HD / 16, NO = HD / 32; constexpr bool DEEP = (HD == 64) && !F32KV && (KT == 64);
    const int tid = tidx(), w = __builtin_amdgcn_readfirstlane(tid >> 6), lane = tid & 63, r32 = lane & 31, h = lane >> 5;
    int qrow = 32 * w + r32; if (qrow >= nq_valid) qrow = nq_valid - 1;
    bf16x8 qf[ND];
#pragma unroll
    for (int d0 = 0; d0 < ND; ++d0) qf[d0] = *(const bf16x8*)(Q + (size_t)qrow * ldq + 16 * d0 + 8 * h);
    const bool wave_active = (32 * w < nq_valid);
    const int qpos = qpos0 + 32 * w + r32;
    f32x16 o[NO];
#pragma unroll
    for (int i = 0; i < NO; ++i)
#pragma unroll
        for (int r = 0; r < 16; ++r) o[i][r] = 0.f;
    float m_run = -1e30f, l_run = 0.f;
    const int NT = (n_keys + KT - 1) / KT;
    u32x4 krA[NL], vrA[NL], krB[NL], vrB[NL]; f32x4 kraw[2], vraw[2];
#define ATT_GLOAD(t, kr, vr) do { if (F32KV && (t) < nf32) { const int row_ = tid / CH, ch_ = tid % CH; const size_t go_ = (size_t)((t) * 64 + row_) * 512 + ch_ * 8; \
        kraw[0] = __builtin_nontemporal_load((const f32x4*)(Kf + go_)); kraw[1] = __builtin_nontemporal_load((const f32x4*)(Kf + go_ + 4)); vraw[0] = __builtin_nontemporal_load((const f32x4*)(Vf + go_)); vraw[1] = __builtin_nontemporal_load((const f32x4*)(Vf + go_ + 4)); } else { \
        _Pragma("unroll") for (int i_ = 0; i_ < NL; ++i_) { const int idx_ = tid + NTHR * i_, row_ = idx_ / CH, ch_ = idx_ % CH; const size_t go_ = (size_t)(((t) - nf32) * KT + row_) * ldk + ch_ * 8; \
        kr[i_] = *(const u32x4*)(Kp + go_); vr[i_] = *(const u32x4*)(Vp + go_); } } } while (0)
#define ATT_LWRITE(buf, t, kr, vr) do { if (F32KV && (t) < nf32) { kr[0].x = pk2(kraw[0].x, kraw[0].y); kr[0].y = pk2(kraw[0].z, kraw[0].w); kr[0].z = pk2(kraw[1].x, kraw[1].y); kr[0].w = pk2(kraw[1].z, kraw[1].w); \
        vr[0].x = pk2(vraw[0].x, vraw[0].y); vr[0].y = pk2(vraw[0].z, vraw[0].w); vr[0].z = pk2(vraw[1].x, vraw[1].y); vr[0].w = pk2(vraw[1].z, vraw[1].w); } \
        unsigned char* kb_ = lds + (buf) * BUF; unsigned char* vb_ = kb_ + KBY; _Pragma("unroll") for (int i_ = 0; i_ < NL; ++i_) { const int idx_ = tid + NTHR * i_, row_ = idx_ / CH, ch_ = idx_ % CH; \
        *(u32x4*)(kb_ + row_ * KP + ch_ * 16) = kr[i_]; *(u32x4*)(vb_ + row_ * VP + ch_ * 16) = vr[i_]; } } while (0)
#define ATT_COMPUTE(TT_) do { const int t = (TT_); \
        const bool doit = wave_active && (!FOX || (t * KT <= qpos0 + 32 * w + 31)); \
        if (doit) { \
            const unsigned char* Kb = lds + (t & 1) * BUF; const unsigned char* Vb = Kb + KBY; \
            f32x16 p[NTT]; \
_Pragma("unroll") \
            for (int tt = 0; tt < NTT; ++tt) { \
                f32x16 c; \
                if (FOX) { \
_Pragma("unroll") \
                    for (int g = 0; g < 4; ++g) { const f32x4 bv = *(const f32x4*)(biasL + t * KT + 32 * tt + 8 * g + 4 * h); c[4 * g] = bv.x; c[4 * g + 1] = bv.y; c[4 * g + 2] = bv.z; c[4 * g + 3] = bv.w; } \
                } else { \
_Pragma("unroll") \
                    for (int r = 0; r < 16; ++r) c[r] = 0.f; \
                } \
_Pragma("unroll") \
                for (int d0 = 0; d0 < ND; ++d0) { const bf16x8 a = *(const bf16x8*)(Kb + (32 * tt + r32) * KP + (16 * d0 + 8 * h) * 2); c = MFMA32(a, qf[d0], c); } \
                p[tt] = c; \
            } \
            if (FOX && (t * KT + KT - 1 > qpos0 + 32 * w)) { \
                const int qrel = qpos - t * KT - 4 * h; \
_Pragma("unroll") \
                for (int tt = 0; tt < NTT; ++tt) \
_Pragma("unroll") \
                    for (int r = 0; r < 16; ++r) { if (32 * tt + (r & 3) + 8 * (r >> 2) > qrel) p[tt][r] = -__builtin_inff(); } \
            } \
            float mx = 0.f; \
_Pragma("unroll") \
            for (int tt = 0; tt < NTT; ++tt) { float ma = fmaxf(fmaxf(p[tt][0], p[tt][1]), p[tt][2]); \
_Pragma("unroll") \
                for (int r = 3; r < 15; r += 2) ma = fmaxf(fmaxf(ma, p[tt][r]), p[tt][r + 1]); \
                ma = fmaxf(ma, p[tt][15]); mx = tt == 0 ? ma : fmaxf(mx, ma); } \
            { auto rr = __builtin_amdgcn_permlane32_swap(__float_as_uint(mx), __float_as_uint(mx), false, false); mx = fmaxf(__uint_as_float(rr[0]), __uint_as_float(rr[1])); } \
            if (__any(mx > m_run + 20.0f)) { \
                const float mnew = fmaxf(m_run, mx); const float alpha = __builtin_amdgcn_exp2f(m_run - mnew); \
                l_run *= alpha; m_run = mnew; \
_Pragma("unroll") \
                for (int i = 0; i < NO; ++i) o[i] = o[i] * alpha; \
            } \
            f32x2v ls2 = (f32x2v){0.f, 0.f}; const f32x2v nm2 = (f32x2v){-m_run, -m_run}; \
_Pragma("unroll") \
            for (int tt = 0; tt < NTT; ++tt) \
_Pragma("unroll") \
                for (int r = 0; r < 16; r += 2) { f32x2v x = (f32x2v){p[tt][r], p[tt][r + 1]} + nm2; x.x = __builtin_amdgcn_exp2f(x.x); x.y = __builtin_amdgcn_exp2f(x.y); p[tt][r] = x.x; p[tt][r + 1] = x.y; ls2 += x; } \
            l_run += ls2.x + ls2.y; \
_Pragma("unroll") \
            for (int ks = 0; ks < NKS; ++ks) { \
                const int tt = ks >> 1, s = ks & 1; \
                u32x4 pw; pw.x = pk2(p[tt][8 * s + 0], p[tt][8 * s + 1]); pw.y = pk2(p[tt][8 * s + 2], p[tt][8 * s + 3]); pw.z = pk2(p[tt][8 * s + 4], p[tt][8 * s + 5]); pw.w = pk2(p[tt][8 * s + 6], p[tt][8 * s + 7]); \
                const bf16x8 pb = __builtin_bit_cast(bf16x8, pw); \
_Pragma("unroll") \
                for (int db = 0; db < NO; ++db) { \
                    const LAS3 unsigned char* vp = (const LAS3 unsigned char*)Vb + (32 * tt + 16 * s + 4 * h + ((lane & 15) >> 2)) * VP + 64 * db + 8 * (4 * ((lane >> 4) & 1) + (lane & 3)); \
                    const s16x4v lo = __builtin_amdgcn_ds_read_tr16_b64_v4i16((LAS3 s16x4v*)vp), hi = __builtin_amdgcn_ds_read_tr16_b64_v4i16((LAS3 s16x4v*)(vp + 8 * VP)); \
                    const bf16x8 av = (bf16x8){lo[0], lo[1], lo[2], lo[3], hi[0], hi[1], hi[2], hi[3]}; \
                    o[db] = MFMA32(av, pb, o[db]); \
                } \
            } \
        } \
    } while (0)
    ATT_GLOAD(0, krA, vrA);
    if (FOX) fox_bias((float*)biasL, fb_wsum, fb_s1, fb_n1, fb_s2, n_keys, fb_npad);
    __syncthreads();
    ATT_LWRITE(0, 0, krA, vrA);
    __syncthreads();
    if (DEEP) {
        if (1 < NT) ATT_GLOAD(1, krA, vrA);
        for (int tl = 0; tl < NT; tl += 2) {
            if (tl + 2 < NT) ATT_GLOAD(tl + 2, krB, vrB);
            ATT_COMPUTE(tl);
            if (tl + 1 < NT) ATT_LWRITE((tl + 1) & 1, tl + 1, krA, vrA);
            __syncthreads();
            if (tl + 1 < NT) {
                if (tl + 3 < NT) ATT_GLOAD(tl + 3, krA, vrA);
                ATT_COMPUTE(tl + 1);
                if (tl + 2 < NT) ATT_LWRITE(tl & 1, tl + 2, krB, vrB);
                __syncthreads();
            }
        }
    } else {
        for (int tl = 0; tl < NT; ++tl) {
            if (tl + 1 < NT) ATT_GLOAD(tl + 1, krA, vrA);
            ATT_COMPUTE(tl);
            if (tl + 1 < NT) ATT_LWRITE((tl + 1) & 1, tl + 1, krA, vrA);
            __syncthreads();
        }
    }
#undef ATT_COMPUTE
#undef ATT_GLOAD
#undef ATT_LWRITE
    const float lt = l_run + __shfl_xor(l_run, 32);
    const float inv = 1.0f / lt;
    if (32 * w + r32 < nq_valid) {
        bf16_t* op = O + (size_t)(32 * w + r32) * ldo;
#pragma unroll
        for (int db = 0; db < NO; ++db)
#pragma unroll
            for (int g = 0; g < 4; ++g) { u32x2 wv; wv.x = pk2(o[db][4 * g] * inv, o[db][4 * g + 1] * inv); wv.y = pk2(o[db][4 * g + 2] * inv, o[db][4 * g + 3] * inv);
                if (frow0 < 0) *(u32x2*)(op + 32 * db + 8 * g + 4 * h) = wv; else *(u32x2*)(O + foff(frow0 + 32 * w + r32, fcol0 + 32 * db + 8 * g + 4 * h, 1024)) = wv; }
    }
}

__device__ __forceinline__ void fox_bias(float* biasL, float* wsum  , const float* s1, int n1, const float* s2, int n, int npad) {
    const int tid = tidx(), lane = tid & 63, w = tid >> 6;
    float v[9]; float run = 0.f;
#pragma unroll
    for (int i = 0; i < 9; ++i) { const int p = tid * 9 + i; float x = 0.f; if (p < n) x = (p < n1) ? s1[(size_t)p * 8] : s2[(size_t)(p - n1) * 8]; run += x; v[i] = run; }
    float incl = run;
#pragma unroll
    for (int off = 1; off < 64; off <<= 1) { const float y = __shfl_up(incl, off); if (lane >= off) incl += y; }
    if (lane == 63) wsum[w] = incl;
    __syncthreads();
    float base = incl - run;
    for (int ww = 0; ww < w; ++ww) base += wsum[ww];
#pragma unroll
    for (int i = 0; i < 9; ++i) { const int p = tid * 9 + i; if (p < npad) biasL[p] = (p < n) ? -(base + v[i]) * LOG2E : 0.f; }
    __syncthreads();
}

__device__ __forceinline__ void pool_unit(unsigned char* lds, const Params& p, int unit) {
    const int tid = tidx(), w = tid >> 6, lane = tid & 63, r32 = lane & 31, h = lane >> 5;
    constexpr int XP = 272;
    unsigned char* X = lds; unsigned char* Ap = lds + 144 * XP;
    const bf16_t* MI = (const bf16_t*)(p.ws + WS_MI); bf16_t* CAT = (bf16_t*)(p.ws + WS_CAT); const bf16_t* WpT = (const bf16_t*)(p.ws + WS_WPOOL);
    const float* scale = p.in[16];
    int g, b, t0, nrows, rowbase; bool sample;
    if (unit < 512) { const int tile = unit >> 2; g = unit & 3; b = tile >> 5; t0 = (tile & 31) * 128; nrows = 128; rowbase = b * SEQ; sample = false; }
    else { const int s = unit - 512; b = s >> 2; g = s & 3; t0 = 0; nrows = 16; rowbase = MP + b * DS; sample = true; }
    const int win = 2 << g;
    for (int idx = tid; idx < (15 + nrows) * 16; idx += NTHR) {
        const int j = idx >> 4, ch = idx & 15; const int t = t0 - 15 + j; u32x4 v = (u32x4){0u, 0u, 0u, 0u};
        if (!sample) { if (t >= 0) v = *(const u32x4*)(MI + (size_t)(rowbase + t) * 512 + g * 128 + ch * 8); }
        else if (j < 15) { const float* cp = p.in[2] + ((size_t)(b * 15 + j) * 512 + g * 128 + ch * 8); const f32x4 a = *(const f32x4*)cp, c = *(const f32x4*)(cp + 4);
            v.x = pk2(a.x, a.y); v.y = pk2(a.z, a.w); v.z = pk2(c.x, c.y); v.w = pk2(c.z, c.w); }
        else v = *(const u32x4*)(MI + (size_t)(rowbase + (j - 15)) * 512 + g * 128 + ch * 8);
        *(u32x4*)(X + j * XP + ch * 16) = v;
    }
    __syncthreads();
    if (sample) { for (int idx = tid; idx < 15 * 128; idx += NTHR) { const int i = idx >> 7, c = idx & 127; p.out[O_PSS + (size_t)(b * 15 + i) * 512 + g * 128 + c] = bf2f(*(const unsigned short*)(X + (16 + i) * XP + c * 2)); } }
    else if (t0 == SEQ - 128) { for (int idx = tid; idx < 15 * 128; idx += NTHR) { const int i = idx >> 7, c = idx & 127; p.out[O_PSP + (size_t)(b * 15 + i) * 512 + g * 128 + c] = bf2f(*(const unsigned short*)(X + (128 + i) * XP + c * 2)); } }
    {
        const int c = tid & 127, r0 = (tid >> 7) * 32;
        if (r0 < nrows) {
            const int nr = (nrows - r0) < 32 ? (nrows - r0) : 32;
            float s = 0.f;
            for (int j = 1; j < win; ++j) s += bf2f(*(const unsigned short*)(X + (15 + r0 - j) * XP + c * 2));
            for (int t = r0; t < r0 + nr; ++t) {
                const float xv = bf2f(*(const unsigned short*)(X + (15 + t) * XP + c * 2)); s += xv;
                int cnt = win; if (!sample) { const int ta = t0 + t + 1; cnt = ta < win ? ta : win; }
                const float pooled = s / (float)cnt - xv;
                *(unsigned short*)(Ap + t * XP + c * 2) = f2bf(pooled);
                s -= bf2f(*(const unsigned short*)(X + (15 + t - (win - 1)) * XP + c * 2));
            }
        }
    }
    __syncthreads();
    {
        const int tb = w & 3, dh = w >> 2;
        if (32 * tb < nrows) {
            f32x16 acc[2];
#pragma unroll
            for (int i = 0; i < 2; ++i)
#pragma unroll
                for (int r = 0; r < 16; ++r) acc[i][r] = 0.f;
#pragma unroll
            for (int ks = 0; ks < 8; ++ks) {
                const bf16x8 bfr = *(const bf16x8*)(Ap + (32 * tb + r32) * XP + (16 * ks + 8 * h) * 2);
#pragma unroll
                for (int db = 0; db < 2; ++db) { const bf16x8 a = *(const bf16x8*)(WpT + ((size_t)(g * 128 + 64 * dh + 32 * db + r32) * 128 + 16 * ks + 8 * h)); acc[db] = MFMA32(a, bfr, acc[db]); }
            }
            const int t = 32 * tb + r32;
            if (t < nrows) {
                bf16_t* op = CAT + (size_t)(rowbase + t0 + t) * 1024 + g * 128; bf16_t* opf = CAT + (size_t)MP * 1024;
#pragma unroll
                for (int db = 0; db < 2; ++db)
#pragma unroll
                    for (int q = 0; q < 4; ++q) { const int d = 64 * dh + 32 * db + 8 * q + 4 * h; const f32x4 sc = *(const f32x4*)(scale + g * 128 + d);
                        u32x2 wv; wv.x = pk2(acc[db][4 * q] * sc.x, acc[db][4 * q + 1] * sc.y); wv.y = pk2(acc[db][4 * q + 2] * sc.z, acc[db][4 * q + 3] * sc.w);
                        if (!sample) *(u32x2*)(op + d) = wv; else *(u32x2*)(opf + foff(b * DS + t, g * 128 + d, 1024)) = wv; }
            }
        }
    }
    __syncthreads();
}

__device__ __forceinline__ void mem_unit(unsigned char* lds, const Params& p, int l, int unit) {
    const bf16_t* MQ = (const bf16_t*)(p.ws + WS_MQ); bf16_t* CAT = (bf16_t*)(p.ws + WS_CAT);
    size_t row0; int hd, nq, ldk; const bf16_t* k; const bf16_t* v;
    if (unit < 256) {
        const int b = unit >> 6, qb = unit & 15; hd = (unit >> 4) & 3; row0 = (size_t)b * SEQ + qb * 256; nq = 256; ldk = 1024;
        k = (const bf16_t*)(p.ws + WS_MKVP) + (size_t)l * 1024 * 1024 + (size_t)b * NMEM * 1024 + hd * 128; v = k + 512;
    } else {
        const int s = unit - 256, b = s >> 2; hd = s & 3; row0 = (size_t)MP + b * DS; nq = DS; ldk = 512;
        k = (const bf16_t*)(p.ws + WS_MKS) + ((size_t)l * DB * NMEM + (size_t)b * NMEM) * 512 + hd * 128;
        v = (const bf16_t*)(p.ws + WS_MVS) + ((size_t)l * DB * NMEM + (size_t)b * NMEM) * 512 + hd * 128;
    }
    if (unit < 256) attn_unit<128, false>(lds, MQ + row0 * 512 + hd * 128, 512, nq, k, v, ldk, NMEM, 0, nullptr, CAT + row0 * 1024 + 512 + hd * 128, 1024);
    else attn_unit<128, false>(lds, MQ + row0 * 512 + hd * 128, 512, nq, k, v, ldk, NMEM, 0, nullptr, CAT + (size_t)MP * 1024, 1024, nullptr, nullptr, 0, (int)(row0 - MP), 512 + hd * 128);
}
__device__ __forceinline__ void fox_unit(unsigned char* lds, const Params& p, int unit) {
    const bf16_t* MI = (const bf16_t*)(p.ws + WS_MI); bf16_t* CAT = (bf16_t*)(p.ws + WS_CAT);
    float* biasL = (float*)(lds + 86016); float* wsum = (float*)(lds + 86016 + 18432);
    size_t row0; int hd, nq, nk, n1, npad, qpos0, nf32 = 0; const float* s1; const float* s2; const bf16_t* k; const bf16_t* v; const float* kf = nullptr; const float* vf = nullptr;
    if (unit < 512) {
        const int qb = 15 - (unit >> 5), bh = unit & 31, b = bh >> 3; hd = bh & 7; const size_t rowb = (size_t)b * SEQ; nk = (qb + 1) * 256; n1 = nk; npad = nk; nq = 256; qpos0 = qb * 256;
        row0 = rowb + qb * 256; s1 = p.out + O_LFP + rowb * 8 + hd; s2 = s1;
        k = (const bf16_t*)(p.ws + WS_KB) + rowb * 512 + hd * 64; v = (const bf16_t*)(p.ws + WS_VB) + rowb * 512 + hd * 64;
    } else {
        const int s = unit - 512, b = s >> 3; hd = s & 7; row0 = (size_t)MP + b * DS; nk = PAST + DS; n1 = PAST; npad = LKS; nq = DS; qpos0 = PAST;
        s1 = p.in[5] + (size_t)b * PAST * 8 + hd; s2 = p.out + O_LFS + (size_t)b * DS * 8 + hd;
        k = (const bf16_t*)(p.ws + WS_KSB) + (size_t)b * NKS * 512 + hd * 64; v = (const bf16_t*)(p.ws + WS_VSB) + (size_t)b * NKS * 512 + hd * 64;
        kf = p.in[3] + (size_t)b * PAST * 512 + hd * 64; vf = p.in[4] + (size_t)b * PAST * 512 + hd * 64; nf32 = PAST / 64;
    }
    const bool smp = unit >= 512;
    if (!smp) attn_unit<64, true, false>(lds, MI + row0 * 512 + hd * 64, 512, nq, k, v, 512, nk, qpos0, biasL, CAT + row0 * 1024 + hd * 64, 1024, nullptr, nullptr, 0, -1, 0, s1, n1, s2, npad, wsum);
    else attn_unit<64, true, true>(lds, MI + row0 * 512 + hd * 64, 512, nq, k, v, 512, nk, qpos0, biasL, CAT + (size_t)MP * 1024, 1024, kf, vf, nf32, (int)(row0 - MP), hd * 64, s1, n1, s2, npad, wsum);
}

__device__ __forceinline__ void cvt_unit(unsigned char* lds, const Params& p, int unit) {
    const int tid = tidx(), lane = tid & 63, wave = __builtin_amdgcn_readfirstlane(tid >> 6);
    float* scr = (float*)(lds + wave * 16640);
    constexpr int I_SQ = 16 * 16, I_UP = 16 * 64, I_DN = 64 * 16;
    int r = unit * 8 + wave;
    const float* W; const float* gain = nullptr; bf16_t* WT; int K = 1024, N = 1024, ldw = 1024;
    if (r < I_SQ) { W = p.in[13] + 1048576; gain = p.in[9] + 1024; WT = (bf16_t*)(p.ws + WS_WINKV); }
    else if ((r -= I_SQ) < I_SQ) { W = p.in[18]; ldw = 1032; gain = p.in[17]; WT = (bf16_t*)(p.ws + WS_WINKV) + 1048576; }
    else if ((r -= I_SQ) < I_SQ) { W = p.in[14]; WT = (bf16_t*)(p.ws + WS_WOUT); }
    else if ((r -= I_SQ) < I_SQ) { W = p.in[14] + 1048576; WT = (bf16_t*)(p.ws + WS_WOUT) + 1048576; }
    else if ((r -= I_SQ) < I_UP) { W = p.in[22]; N = 4096; ldw = 4096; gain = p.in[11]; WT = (bf16_t*)(p.ws + WS_WUP); }
    else if ((r -= I_UP) < I_UP) { W = p.in[22] + 4194304; N = 4096; ldw = 4096; gain = p.in[11] + 1024; WT = (bf16_t*)(p.ws + WS_WUP) + 4194304; }
    else if ((r -= I_UP) < I_DN) { W = p.in[23]; K = 4096; WT = (bf16_t*)(p.ws + WS_WDN); }
    else { r -= I_DN; W = p.in[23] + 4194304; K = 4096; WT = (bf16_t*)(p.ws + WS_WDN) + 4194304; }
    transpose_item(W, K, N, ldw, gain, WT, scr, r, lane);
}

#define LAS __attribute__((address_space(3)))
#define XB_TMO      128
#define XB_XCNT(j)  (256  + 64 * (j))
#define XB_XSUB(j)  (1280 + 64 * (j))
#define XB_XGEN(j)  (2304 + 64 * (j))
#define XB_TOP      3328
#define XB_TOPGEN   3392
#define XCD_BAR_WORDS 3456
#define XB_SPIN_CAP (1u << 18)

__device__ __forceinline__ unsigned xb_ld(unsigned* p)              { return __hip_atomic_load(p, __ATOMIC_RELAXED, __HIP_MEMORY_SCOPE_AGENT); }
__device__ __forceinline__ unsigned xb_add(unsigned* p, unsigned v) { return __hip_atomic_fetch_add(p, v, __ATOMIC_RELAXED, __HIP_MEMORY_SCOPE_AGENT); }
__device__ __forceinline__ unsigned xb_xcc_id() { return (unsigned)__builtin_amdgcn_s_getreg((3 << 11) | 20) & 0xFu; }
#define XB_SPIN(cond, bar) do { unsigned _sp = 0; while (cond) { __builtin_amdgcn_s_sleep(1); \
    if ((++_sp & 255u) == 0u) { if (xb_ld(&(bar)[XB_TMO])) break; if (_sp > XB_SPIN_CAP) { atomicAdd(&(bar)[XB_TMO], 1u); break; } } } } while (0)

struct XcdBarrier {
    unsigned* bar; unsigned x;
    volatile LAS unsigned* st;
};

__device__ __forceinline__ XcdBarrier xcd_barrier_post(unsigned* bar, volatile LAS unsigned* st) {
    XcdBarrier b; b.bar = bar; b.x = xb_xcc_id(); b.st = st;
    if (tidx() == 0) (void)xb_add(&bar[XB_XCNT(b.x)], 1u);
    return b;
}
__device__ __forceinline__ void xcd_barrier_complete(unsigned* bar, unsigned x, unsigned& nloc, unsigned& nx) {
    const unsigned G = gridDim.x * gridDim.y * gridDim.z;
    unsigned sum, cnt, mine, sp = 0u;
    for (;;) {
        sum = 0u; cnt = 0u; mine = 0u;
#pragma unroll
        for (unsigned j = 0; j < 16; ++j) { const unsigned c = xb_ld(&bar[XB_XCNT(j)]); sum += c; cnt += (c > 0u) ? 1u : 0u; mine = (j == x) ? c : mine; }
        if (sum == G) break;
        __builtin_amdgcn_s_sleep(1);
        if ((++sp & 255u) == 0u) { if (xb_ld(&bar[XB_TMO])) break; if (sp > XB_SPIN_CAP) { atomicAdd(&bar[XB_TMO], 1u); break; } }
    }
    nloc = mine > 0u ? mine : 1u; nx = cnt > 0u ? cnt : 1u;
}

__device__ __forceinline__ void xcd_barrier(const XcdBarrier& b) {
    asm volatile("s_waitcnt vmcnt(0)" ::: "memory");
    __syncthreads();
    if (tidx() == 0) {
        unsigned* bar = b.bar;
        __builtin_amdgcn_s_waitcnt(0);
        unsigned nloc = b.st[0], nx = b.st[1];
        if (nloc == 0u) { xcd_barrier_complete(bar, b.x, nloc, nx); b.st[0] = nloc; b.st[1] = nx; }
        const unsigned old = xb_add(&bar[XB_XSUB(b.x)], 1u);
        const unsigned gen = old / nloc;
        if (old + 1u == (gen + 1u) * nloc) {
            __builtin_amdgcn_fence(__ATOMIC_RELEASE, "agent");
            asm volatile("s_waitcnt vmcnt(0)" ::: "memory");
            const unsigned og = xb_add(&bar[XB_TOP], 1u);
            const unsigned tg = og / nx;
            if (og + 1u == (tg + 1u) * nx) xb_add(&bar[XB_TOPGEN], 1u);
            else XB_SPIN(xb_ld(&bar[XB_TOPGEN]) == tg, bar);
            __builtin_amdgcn_fence(__ATOMIC_ACQUIRE, "agent");
            xb_add(&bar[XB_XGEN(b.x)], 1u);
            asm volatile("s_waitcnt vmcnt(0)" ::: "memory");
        } else {
            XB_SPIN(xb_ld(&bar[XB_XGEN(b.x)]) == gen, bar);
            __builtin_amdgcn_fence(__ATOMIC_ACQUIRE, "agent");
            asm volatile("s_waitcnt vmcnt(0)" ::: "memory");
        }
    }
    __syncthreads();
}

#ifndef ENMASK
#define ENMASK 63
#endif
#define EN(t) (((ENMASK) >> (t)) & 1)
#define IN(k) (lo <= (k) && (k) < hi)
#define SEAM(k) do { if (IN(k) && IN((k) + 1)) xcd_barrier(bar); } while (0)
template <int l>
__device__ __forceinline__ void layer_phases(const Params& p, unsigned char* lds, const XcdBarrier& bar, int lo, int hi) {
    const int tid = tidx(), lane = tid & 63, wave = __builtin_amdgcn_readfirstlane(tid >> 6);
    const int G = gridDim.x, bx = blockIdx.x;
    unsigned* ctl = (unsigned*)(p.ws + WS_CTL);
    float* slots = (float*)(p.ws + WS_SLOTS);
    int* qslot = (int*)(lds + MISC_OFF);
    float* ldsf = (float*)lds;
    PG8_LAS unsigned char* lds3 = (PG8_LAS unsigned char*)lds;
    bf16_t* XN = (bf16_t*)(p.ws + WS_XN);
    float* X = p.out + O_Y;
    float* ssq = (float*)(p.ws + WS_SSQ); float* ssq_s = ssq + (size_t)MP * 16;
    float* rsL = (float*)(lds + RING_BYTES); const PG8_LAS float* rsL3 = (const PG8_LAS float*)(lds3 + RING_BYTES);
    (void)wave; (void)ctl; (void)slots; (void)qslot;
        const int pb = 1 + 5 * l;
        if (EN(1) && IN(pb)) {
            bf16_t* MIb = (bf16_t*)(p.ws + WS_MI); bf16_t* MQb = (bf16_t*)(p.ws + WS_MQ);
            const float smi = l == 0 ? 1.f : CFOX, smq = CMEM;
            const int nsk_s = l == 0 ? 32 : 64, nsk = l == 0 ? 32 + 512 : 64 + 129;
#ifndef PROBE_SK
#define PROBE_SK 1
#endif
            for (int reps = 0; reps < PROBE_SK; ++reps)
            for (int u = bx; u < nsk; u += G) {
                f32x4 o[2];
                if (u < nsk_s) {
                    skinny_gemm(XN + (size_t)MP * DM, (const bf16_t*)(p.ws + (l == 0 ? WS_WIN0 : WS_WINKV)), 1024, 0, u * 32, ldsf, o);
                    const int w = tid >> 6, r32 = lane & 31, h = lane >> 5; const int row = 32 * (w >> 1) + r32;
                    const float rsr = l == 1 ? sample_rs(ssq_s, row) : 1.f;
#pragma unroll
                    for (int g = 0; g < 2; ++g) { const int col = u * 32 + 16 * (w & 1) + 8 * g + 4 * h; const int sec = col >> 9, cc = col & 511; const f32x4 v = o[g] * rsr;
                        if (sec < 2) { const float sc = sec == 0 ? smi : smq; u32x2 wv; wv.x = pk2(v.x * sc, v.y * sc); wv.y = pk2(v.z * sc, v.w * sc); *(u32x2*)((sec == 0 ? MIb : MQb) + (size_t)(MP + row) * 512 + cc) = wv; }
                        else { *(f32x4*)(p.out + (sec == 2 ? O_KS : O_VS) + (size_t)row * 512 + cc) = v; u32x2 wv; wv.x = pk2(v.x, v.y); wv.y = pk2(v.z, v.w);
                            *(u32x2*)((bf16_t*)(p.ws + (sec == 2 ? WS_KSB : WS_VSB)) + ((size_t)(row >> 4) * NKS + (row & 15)) * 512 + cc) = wv; } }
                } else if (l == 1) {
                    const int ug = u - 64;
                    if (ug < 128) skinny_gemm<false>(XN, (const bf16_t*)(p.ws + WS_WF), 1024, ug * 128, 0, ldsf, o);
                    else skinny_gemm<true>(XN + (size_t)MP * DM, (const bf16_t*)(p.ws + WS_WF), 1024, 0, 0, ldsf, o);
                    const int w = tid >> 6, r32 = lane & 31, h = lane >> 5; const int m = ug * 128 + 32 * (w >> 1) + r32;
                    float rsm;
                    if (m < MP) { const f32x4* q = (const f32x4*)(ssq + (size_t)m * 16); float t = 0.f;
#pragma unroll
                        for (int i = 0; i < 4; ++i) { const f32x4 v = q[i]; t += (v.x + v.y) + (v.z + v.w); }
                        rsm = 1.0f / sqrtf(t * (1.0f / 1024.0f) + 1e-6f); }
                    else rsm = sample_rs(ssq_s, m - MP);
                    if ((w & 1) == 0) { const f32x4 bfv = *(const f32x4*)(p.in[19] + 4 * h); f32x4 lf;
#pragma unroll
                        for (int e = 0; e < 4; ++e) { const float v = o[0][e] * rsm + bfv[e]; lf[e] = fminf(v, 0.f) - log1pf(expf(-fabsf(v))); }
                        if (m < MP) *(f32x4*)(p.out + O_LFP + (size_t)m * 8 + 4 * h) = lf; else *(f32x4*)(p.out + O_LFS + (size_t)(m - MP) * 8 + 4 * h) = lf; }
                } else {
                    const int v_ = u - 32, ly = v_ >> 8, rg = (v_ >> 5) & 7, cu = v_ & 31;
                    skinny_gemm((const bf16_t*)(p.ws + WS_MN), (const bf16_t*)(p.ws + WS_WMEM) + (size_t)ly * 1048576, 1024, rg * 128, cu * 32, ldsf, o);
                    const int w = tid >> 6, r32 = lane & 31, h = lane >> 5; const int row = rg * 128 + 32 * (w >> 1) + r32;
#pragma unroll
                    for (int g = 0; g < 2; ++g) { const int col = cu * 32 + 16 * (w & 1) + 8 * g + 4 * h; const f32x4 v = o[g];
                        *(f32x4*)(p.out + (col < 512 ? O_MK : O_MV) + (size_t)ly * 524288 + (size_t)row * 512 + (col & 511)) = v;
                        u32x2 wv; wv.x = pk2(v.x, v.y); wv.y = pk2(v.z, v.w); *(u32x2*)((bf16_t*)(p.ws + WS_MKVP) + (size_t)ly * 1048576 + (size_t)row * 1024 + col) = wv; }
                }
            }
            __syncthreads();
            pg8::Gemm g{XN, (const bf16_t*)(p.ws + (l == 0 ? WS_WIN0 : WS_WINKV)), MP, l == 0 ? 1024 : 2048, 1024};
            pg8::StaticOrder S; S.init(MP, g.N, G, bx);
            if (l == 1) { pg8::Unit u0; if (S.next(0, u0)) panel_rs(ssq, u0.pm, rsL); else __syncthreads(); }
            pg8::EpiProj E{MIb, MQb, (bf16_t*)(p.ws + WS_KB), (bf16_t*)(p.ws + WS_VB), p.out + O_KP, p.out + O_VP, smi, smq, l == 1 ? rsL3 : (const PG8_LAS float*)nullptr};
            pg8::gemm_phase<pg8::EpiProj, pg8::StaticOrder, true, true>(lds3, g, S, E);
#ifndef PROBE_PROJ
#define PROBE_PROJ 1
#endif
            if (PROBE_PROJ > 1 && l == 0) { __syncthreads(); pg8::gemm_phase<pg8::EpiProj, pg8::StaticOrder, true, true>(lds3, g, S, E); }
        }
        SEAM(pb);
        if (EN(2) && IN(pb + 1)) {
#ifndef PROBE_MIX
#define PROBE_MIX 1
#endif
            #ifndef PROBE_MIX_L
#define PROBE_MIX_L 1
#endif
            for (int rep = 0; rep < (l == PROBE_MIX_L ? PROBE_MIX : 1); ++rep) {
            unsigned* qc = ctl + CW_Q + 64 * (l + 2 * rep);
            const int nunits = l == 0 ? (640 + 256 + 544 + 32) : (576 + 288);
            for (;;) {
                __syncthreads();
                if (tid == 0) *qslot = (int)atomicAdd(qc, 1u);
                __syncthreads();
                const int u = *qslot;
                if (u >= nunits) break;
                if (l == 0) { const bool cv = u < 1280 && (u & 1) == 0; const int cu = u < 1280 ? (u >> 1) : u - 640;
                    if (cv) cvt_unit(lds, p, u >> 1); else if (cu >= 256 && cu < 800) pool_unit(lds, p, cu - 256); else mem_unit(lds, p, 0, cu < 256 ? cu : cu - 544); }
                else { if (u < 576) fox_unit(lds, p, u < 64 ? 512 + u : u - 64); else mem_unit(lds, p, 1, u - 576); }
            }
            }
            __syncthreads();
        }
        SEAM(pb + 1);
        if (EN(3) && IN(pb + 2)) {
            const float* bases = l == 0 ? p.in[1] : X + (size_t)MP * DM;
            const int bk = 2 * l;
            float* sl1 = slots + (size_t)bk * SLOT_BANK; unsigned* c1 = ctl + CW_CNT + bk * 80 * 64;
            const bf16_t* Wt = (const bf16_t*)(p.ws + WS_WOUT) + (size_t)l * 1048576;
            for (int u = bx; u < 32; u += G) {
                f32x4 o[2];
                skinny_gemm((const bf16_t*)(p.ws + WS_CAT) + (size_t)MP * DM, Wt, 1024, 0, u * 32, ldsf, o);
                skinny_norm(o, u, bases, X + (size_t)MP * DM, XN + (size_t)MP * DM, ssq_s, p.in[10] + l * 1024, sl1 + 65536, c1 + 64 * 64, ldsf);
            }
            __syncthreads();
            pg8::Gemm g{(const bf16_t*)(p.ws + WS_CAT), Wt, MP, 1024, 1024};
            pg8::StaticOrder S; S.init(MP, 1024, G, bx);
            if (l == 0) { pg8::EpiNorm<true, false> E{p.in[0], nullptr, XN, ssq, p.in[10] + l * 1024, sl1, c1}; pg8::gemm_phase<pg8::EpiNorm<true, false>, pg8::StaticOrder, false, true>(lds3, g, S, E); }
            else { pg8::EpiNorm<false, false> E{XN, nullptr, XN, ssq, p.in[10] + l * 1024, sl1, c1}; pg8::gemm_phase<pg8::EpiNorm<false, false>, pg8::StaticOrder, false, true>(lds3, g, S, E); }
        }
        SEAM(pb + 2);
        if (EN(4) && IN(pb + 3)) {
            const bf16_t* Wt = (const bf16_t*)(p.ws + WS_WUP) + (size_t)l * 4194304; bf16_t* HB = (bf16_t*)(p.ws + WS_HB);
            for (int reps = 0; reps < PROBE_SK; ++reps)
            for (int u = bx; u < 128; u += G) {
                f32x4 o[2];
                skinny_gemm(XN + (size_t)MP * DM, Wt, 1024, 0, u * 32, ldsf, o);
                const int w = tid >> 6, r32 = lane & 31, h = lane >> 5; const int row = 32 * (w >> 1) + r32; const float rsr = sample_rs(ssq_s, row);
#pragma unroll
                for (int g = 0; g < 2; ++g) { const int col = u * 32 + 16 * (w & 1) + 8 * g + 4 * h; f32x4 v = o[g];
#pragma unroll
                    for (int e = 0; e < 4; ++e) { const float a = (v[e] > 0.f ? v[e] : 0.f) * rsr; v[e] = a * a; }
                    u32x2 wv; wv.x = pk2(v.x, v.y); wv.y = pk2(v.z, v.w); *(u32x2*)(HB + (size_t)MP * FF + foff(row, col, FF)) = wv; }
            }
            __syncthreads();
            pg8::Gemm g{XN, Wt, MP, FF, 1024};
            pg8::StaticOrder S; S.init(MP, FF, G, bx);
            { pg8::Unit u0; if (S.next(0, u0)) panel_rs(ssq, u0.pm, rsL); else __syncthreads(); }
            pg8::EpiUp E{HB, FF, rsL3};
#ifndef PROBE_UP
#define PROBE_UP 1
#endif
            pg8::gemm_phase<pg8::EpiUp, pg8::StaticOrder, true, true>(lds3, g, S, E);
            if (PROBE_UP > 1 && l == 0) { __syncthreads(); pg8::gemm_phase<pg8::EpiUp, pg8::StaticOrder, true, true>(lds3, g, S, E); }
        }
        SEAM(pb + 3);
        if (EN(5) && IN(pb + 4)) {
            const int bk = 2 * l + 1;
            float* sl1 = slots + (size_t)bk * SLOT_BANK; unsigned* c1 = ctl + CW_CNT + bk * 80 * 64;
            const bf16_t* Wt = (const bf16_t*)(p.ws + WS_WDN) + (size_t)l * 4194304; const bf16_t* HB = (const bf16_t*)(p.ws + WS_HB);
            for (int u = bx; u < 32; u += G) {
                f32x4 o[2];
                skinny_gemm(HB + (size_t)MP * FF, Wt, FF, 0, u * 32, ldsf, o);
                skinny_norm(o, u, X + (size_t)MP * DM, X + (size_t)MP * DM, l == 0 ? XN + (size_t)MP * DM : nullptr, ssq_s, p.in[12] + l * 1024, sl1 + 65536, c1 + 64 * 64, ldsf);
            }
            __syncthreads();
            int Kd = FF; asm volatile("" : "+s"(Kd));
            pg8::Gemm g{HB, Wt, MP, 1024, Kd};
            pg8::StaticOrder S; S.init(MP, 1024, G, bx);
            if (l == 0) { pg8::EpiNorm<false, false> E{XN, nullptr, XN, ssq, p.in[12] + l * 1024, sl1, c1}; pg8::gemm_phase<pg8::EpiNorm<false, false>, pg8::StaticOrder, false, true>(lds3, g, S, E); }
            else { pg8::EpiNorm<false, true> E{XN, X, nullptr, nullptr, p.in[12] + l * 1024, sl1, c1}; pg8::gemm_phase<pg8::EpiNorm<false, true>, pg8::StaticOrder, false, true>(lds3, g, S, E); }
        }
        if (l == 0) SEAM(pb + 4);

}
__global__ void __launch_bounds__(NTHR, 2) yoco_fwd(Params p) {
    unsigned char* lds = lds_raw_;
    cg::grid_group grid = cg::this_grid();
    { const unsigned key = (unsigned)__builtin_amdgcn_s_getreg((5 << 11) | 4) & 63u; if ((threadIdx.x & 63) == 0) ((volatile int*)(lds_raw_ + TIDX_LDS_OFF))[key] = (int)(threadIdx.x >> 6); }
    __syncthreads();
    const int tid = tidx(), lane = tid & 63, wave = __builtin_amdgcn_readfirstlane(tid >> 6);
    const int G = gridDim.x, bx = blockIdx.x;
    unsigned* ctl = (unsigned*)(p.ws + WS_CTL);
    float* slots = (float*)(p.ws + WS_SLOTS);
    int* qslot = (int*)(lds + MISC_OFF);
    float* ldsf = (float*)lds;
    PG8_LAS unsigned char* lds3 = (PG8_LAS unsigned char*)lds;
    bf16_t* XN = (bf16_t*)(p.ws + WS_XN);
    float* X = p.out + O_Y;
    const int lo = p.ph_lo, hi = p.ph_hi;
    if (tid < 32) ((volatile unsigned*)(lds + MISC_OFF))[tid] = 0u;
    __syncthreads();
    XcdBarrier bar = xcd_barrier_post(ctl + CW_BAR, (volatile LAS unsigned*)(lds + MISC_OFF) + 8);

#ifndef PROBE_P0
#define PROBE_P0 1
#endif
    if (EN(0) && IN(0)) for (int rep0 = 0; rep0 < PROBE_P0; ++rep0) {
        float* scr = (float*)(lds + wave * 16640);
        const int gw = bx * 8 + wave, NGW = G * 8;
        constexpr int I_SQ = 16 * 16, I_PL = 2 * 2;
        constexpr int NITEMS = 3 * I_SQ + 4 * I_PL;
        for (int it = gw; it < NITEMS; it += NGW) {
            int r = it;
            if (r < I_SQ) { transpose_item(p.in[13], 1024, 1024, 1024, p.in[9], (bf16_t*)(p.ws + WS_WIN0), scr, r, lane); continue; } r -= I_SQ;
            if (r < I_SQ) { transpose_item(p.in[21], 1024, 1024, 1024, p.in[20], (bf16_t*)(p.ws + WS_WMEM), scr, r, lane); continue; } r -= I_SQ;
            if (r < I_SQ) { transpose_item(p.in[21] + 1048576, 1024, 1024, 1024, p.in[20] + 1024, (bf16_t*)(p.ws + WS_WMEM) + 1048576, scr, r, lane); continue; } r -= I_SQ;
            { const int gq = r / I_PL; transpose_item(p.in[15] + gq * 16384, 128, 128, 128, nullptr, (bf16_t*)(p.ws + WS_WPOOL) + gq * 16384, scr, r % I_PL, lane); }
        }
        for (int m = gw; m < MT + 1024; m += NGW) {
            if (m < MP) norm_row_to_bf16(p.in[0] + (size_t)m * DM, XN + (size_t)m * DM, lane);
            else if (m < MT) norm_row_to_bf16(p.in[1] + (size_t)(m - MP) * DM, XN + (size_t)MP * DM, lane, m - MP);
            else norm_row_to_bf16(p.in[8] + (size_t)(m - MT) * DM, (bf16_t*)(p.ws + WS_MN), lane, m - MT);
        }
        const size_t gtid = (size_t)bx * NTHR + tid, gn = (size_t)G * NTHR;
        cvt_rows(p.in[6], (bf16_t*)(p.ws + WS_MKS), (size_t)2 * DB * NMEM * 512 / 8, 64, 1, 1, gtid, gn);
        cvt_rows(p.in[7], (bf16_t*)(p.ws + WS_MVS), (size_t)2 * DB * NMEM * 512 / 8, 64, 1, 1, gtid, gn);
        for (size_t i = gtid; i < 32 * 1024; i += gn) { const int rr = (int)(i >> 10), k = (int)(i & 1023); const float v = rr < 8 ? p.in[17][k] * p.in[18][(size_t)k * 1032 + 1024 + rr] : 0.f; ((bf16_t*)(p.ws + WS_WF))[i] = f2bf(v); }
        __syncthreads();
    }
    SEAM(0);

    layer_phases<0>(p, lds, bar, lo, hi);
    layer_phases<1>(p, lds, bar, lo, hi);
    if (hi > 1000) grid.sync();
#undef IN
#undef SEAM
}

#ifndef MK_N_LAUNCHES
#define MK_N_LAUNCHES 1
#endif
extern "C" void kernel_launch(void* const* d_in, const int* in_sizes, int n_in, void* d_out, int out_size, void* d_ws, size_t ws_size, hipStream_t stream) {
    static int grid = 0;
    if (grid == 0) {
        if (n_in != 24 || ws_size < WS_END) { fprintf(stderr, "kernel_launch: unexpected problem (n_in %d, ws %zu)\n", n_in, ws_size); grid = -1; return; }
        int dev = 0, cus = 0, per_cu = 0;
        if (hipGetDevice(&dev) != hipSuccess || hipDeviceGetAttribute(&cus, hipDeviceAttributeMultiprocessorCount, dev) != hipSuccess) { grid = -1; return; }
        if (hipFuncSetAttribute((const void*)yoco_fwd, hipFuncAttributeMaxDynamicSharedMemorySize, LDS_BYTES) != hipSuccess) { fprintf(stderr, "kernel_launch: hipFuncSetAttribute failed\n"); grid = -1; return; }
        if (hipOccupancyMaxActiveBlocksPerMultiprocessor(&per_cu, (const void*)yoco_fwd, NTHR, LDS_BYTES) != hipSuccess || per_cu < 1) { fprintf(stderr, "kernel_launch: occupancy query says %d\n", per_cu); per_cu = 1; }
        (void)hipGetLastError();
        grid = cus;
        if (grid != 256) fprintf(stderr, "kernel_launch: %d CUs; this kernel is built for 256\n", grid);
    }
    if (grid < 0) return;
    (void)hipMemsetAsync((char*)d_ws + WS_CTL, 0, CTL_BYTES, stream);
    Params a{};
    for (int i = 0; i < 24; ++i) a.in[i] = (const float*)d_in[i];
    a.out = (float*)d_out; a.ws = (unsigned char*)d_ws;
    constexpr int NPH = 11;
    if (MK_N_LAUNCHES == 1) {
        a.ph_lo = 0; a.ph_hi = NPH;
        void* args[] = {&a};
        hipError_t e = hipLaunchCooperativeKernel((const void*)yoco_fwd, dim3(grid), dim3(NTHR), args, LDS_BYTES, stream);
        if (e != hipSuccess) fprintf(stderr, "cooperative launch failed: %s (grid %d)\n", hipGetErrorString(e), grid);
    } else {
        for (int ph = 0; ph < NPH; ++ph) {
            a.ph_lo = ph; a.ph_hi = ph + 1;
            void* args[] = {&a};
            hipError_t e = hipLaunchCooperativeKernel((const void*)yoco_fwd, dim3(grid), dim3(NTHR), args, LDS_BYTES, stream);
            if (e != hipSuccess) { fprintf(stderr, "cooperative launch %d failed: %s (grid %d)\n", ph, hipGetErrorString(e), grid); break; }
        }
    }
}
```

```cpp
#include <hip/hip_runtime.h>
#include <hip/hip_cooperative_groups.h>
#include <cstdio>
#include <cstdint>
namespace cg = cooperative_groups;

#define TIDX_LDS_OFF 146944
extern __shared__ __attribute__((aligned(16))) unsigned char lds_raw_[];
__device__ __forceinline__ int tidx() {
    const unsigned key = (unsigned)__builtin_amdgcn_s_getreg((5 << 11) | 4) & 63u;
    const int wv = __builtin_amdgcn_readfirstlane(((volatile const int*)(lds_raw_ + TIDX_LDS_OFF))[key]);
    return wv * 64 + (int)__builtin_amdgcn_mbcnt_hi(~0u, __builtin_amdgcn_mbcnt_lo(~0u, 0u));
}
namespace pg8 {
#define PG8_LAS __attribute__((address_space(3)))
typedef unsigned short bf16_t;
typedef short bf16x8 __attribute__((ext_vector_type(8)));
typedef float f32x4 __attribute__((ext_vector_type(4)));
typedef unsigned u32x4 __attribute__((ext_vector_type(4)));
constexpr int BM = 256, BK = 64, HALF = 128, HTB = HALF * BK * 2  , STAGE_BYTES = 8 * HTB, NXCD = 8, WGM = 8;

__host__ __device__ __forceinline__ int lds_byte(int r, int c) { const int st = (r >> 4) * 2 + (c >> 5), rr = r & 15, cc = c & 31, ob = rr * 64 + cc * 2; return st * 1024 + (ob ^ (((ob >> 9) & 1) << 5)); }
__host__ __device__ __forceinline__ void stage_rc(int b, int& R, int& C) { const int st = b / 1024, sb = b % 1024, swz = sb ^ (((sb >> 9) & 1) << 5); R = (st >> 1) * 16 + swz / 64; C = (st & 1) * 32 + (swz % 64) / 2; }
__host__ __device__ __forceinline__ int perm32(int rho) { const int n = rho >> 4, i = rho & 15; return 8 * (i >> 2) + 4 * n + (i & 3); }

struct Unit { int pm, pn; };
struct Gemm { const bf16_t* A; const bf16_t* Bt; int M, N, K; };

struct StaticOrder {
    int nM, nN, nwg, G, c;
    __host__ __device__ void init(int M, int N, int G_, int c_) { nM = M / BM; nN = N / BM; nwg = nM * nN; G = G_; c = c_; }
    __host__ __device__ bool next(int i, Unit& u) const {
        const long L = (long)i * G + c; if (L >= nwg) return false;
        int wgid = (int)L; { const int q = nwg / NXCD, r = nwg % NXCD, xcd = wgid % NXCD, off = wgid / NXCD; wgid = (xcd < r ? xcd * (q + 1) : r * (q + 1) + (xcd - r) * q) + off; }
        const int nig = WGM * nN, gid = wgid / nig, fm = gid * WGM, gsz = (nM - fm) < WGM ? (nM - fm) : WGM;
        u.pm = fm + ((wgid % nig) % gsz); u.pn = (wgid % nig) / gsz; return true;
    }
    __device__ __forceinline__ void a_ready(const Unit&) const {}
    __device__ __forceinline__ void done(const Unit&) const {}
};


typedef float f32x2_t __attribute__((ext_vector_type(2))); typedef __bf16 bf16x2_t __attribute__((ext_vector_type(2)));
typedef unsigned u32x2 __attribute__((ext_vector_type(2)));
__device__ __forceinline__ unsigned cvt_pk_bf16(float lo, float hi) { unsigned r; asm volatile("v_cvt_pk_bf16_f32 %0, %1, %2" : "=v"(r) : "v"(lo), "v"(hi)); return r; }
__device__ __forceinline__ unsigned pk2(float lo, float hi) { f32x2_t v = {lo, hi}; bf16x2_t b = __builtin_convertvector(v, bf16x2_t); return __builtin_bit_cast(unsigned, b); }

struct EpiProj {
    static constexpr bool PERM = true, AFTER_DRAIN = false;
    bf16_t* MI; bf16_t* MQ; bf16_t* KB; bf16_t* VB; float* kout; float* vout; float smi, smq; const PG8_LAS float* rs;
    __device__ __forceinline__ void operator()(const f32x4 (&acc)[2][2][4][2], const Unit& u, int wr, int wc, int fr, int fq) const {
        const int row0 = u.pm * BM + wr * 64 + fr; const int sec = u.pn >> 1; const int colt = (u.pn & 1) * 256 + wc * 32 + 8 * fq;
        bf16_t* bdst = sec == 0 ? MI : sec == 1 ? MQ : sec == 2 ? KB : VB; float* fdst = sec == 2 ? kout : sec == 3 ? vout : nullptr; const float sc = sec == 0 ? smi : sec == 1 ? smq : 1.f;
#pragma unroll
        for (int ai = 0; ai < 2; ++ai)
#pragma unroll
            for (int m = 0; m < 4; ++m) { const size_t ro = (size_t)(row0 + ai * HALF + m * 16) * 512 + colt; const float scr = rs ? sc * rs[ai * HALF + wr * 64 + m * 16 + fr] : sc;
#pragma unroll
                for (int bj = 0; bj < 2; ++bj) { const f32x4 v0 = acc[ai][bj][m][0] * scr, v1 = acc[ai][bj][m][1] * scr;
                    u32x4 w; w.x = cvt_pk_bf16(v0[0], v0[1]); w.y = cvt_pk_bf16(v0[2], v0[3]); w.z = cvt_pk_bf16(v1[0], v1[1]); w.w = cvt_pk_bf16(v1[2], v1[3]);
                    *(u32x4*)(bdst + ro + bj * HALF) = w;
                    if (fdst) { __builtin_nontemporal_store(v0, (f32x4*)(fdst + ro + bj * HALF)); __builtin_nontemporal_store(v1, (f32x4*)(fdst + ro + bj * HALF + 4)); } } }
    }
};
struct EpiUp {
    static constexpr bool PERM = true, AFTER_DRAIN = false;
    bf16_t* O; int ldc; const PG8_LAS float* rs;
    __device__ __forceinline__ void operator()(const f32x4 (&acc)[2][2][4][2], const Unit& u, int wr, int wc, int fr, int fq) const {
        const int row0 = u.pm * BM + wr * 64 + fr; const int col0 = u.pn * BM + wc * 32 + 8 * fq;
#pragma unroll
        for (int ai = 0; ai < 2; ++ai)
#pragma unroll
            for (int m = 0; m < 4; ++m) { bf16_t* rowp = O + (size_t)(row0 + ai * HALF + m * 16) * ldc + col0; const float rr = rs[ai * HALF + wr * 64 + m * 16 + fr];
#pragma unroll
                for (int bj = 0; bj < 2; ++bj) { f32x4 v0 = acc[ai][bj][m][0], v1 = acc[ai][bj][m][1];
#pragma unroll
                    for (int i = 0; i < 4; ++i) { const float a = (v0[i] > 0.f ? v0[i] : 0.f) * rr, b = (v1[i] > 0.f ? v1[i] : 0.f) * rr; v0[i] = a * a; v1[i] = b * b; }
                    u32x4 w; w.x = cvt_pk_bf16(v0[0], v0[1]); w.y = cvt_pk_bf16(v0[2], v0[3]); w.z = cvt_pk_bf16(v1[0], v1[1]); w.w = cvt_pk_bf16(v1[2], v1[3]);
                    *(u32x4*)(rowp + bj * HALF) = w; } }
    }
};
template <bool BASE_F32, bool FINAL>
struct EpiNorm {
    static constexpr bool PERM = true, AFTER_DRAIN = true;
    const void* base; float* out; bf16_t* xb; float* ssq; const float* gain; float* slots1; unsigned* cnt1;
    __device__ __forceinline__ void stats(const f32x4 (&v)[2][2][4][2], const Unit& u, int wr, int wc, int fr, int fq, PG8_LAS unsigned char* lds, int wid, int lane, float* slots, unsigned* cnt) const {
        PG8_LAS float* P = (PG8_LAS float*)lds;
        PG8_LAS float* S = (PG8_LAS float*)(lds + 4096);
#pragma unroll
        for (int ai = 0; ai < 2; ++ai)
#pragma unroll
            for (int m = 0; m < 4; ++m) {
                float s = 0.f;
#pragma unroll
                for (int bj = 0; bj < 2; ++bj)
#pragma unroll
                    for (int n = 0; n < 2; ++n) { const f32x4 x = v[ai][bj][m][n]; s += (x[0] * x[0] + x[1] * x[1]) + (x[2] * x[2] + x[3] * x[3]); }
                s += __shfl_xor(s, 16); s += __shfl_xor(s, 32);
                if (fq == 0) P[(ai * HALF + wr * 64 + m * 16 + fr) * 4 + wc] = s;
            }
        asm volatile("s_waitcnt lgkmcnt(0)" ::: "memory"); __builtin_amdgcn_s_barrier(); asm volatile("" ::: "memory");
        const int row = wid * 32 + (lane & 31);
        if (lane < 32) {
            const float s = (P[row * 4 + 0] + P[row * 4 + 1]) + (P[row * 4 + 2] + P[row * 4 + 3]);
            __hip_atomic_store(slots + ((size_t)(u.pm * BM + row) * 4 + u.pn), s, __ATOMIC_RELAXED, __HIP_MEMORY_SCOPE_AGENT);
        }
        asm volatile("s_waitcnt vmcnt(0)" ::: "memory");
        if (lane == 0) __hip_atomic_fetch_add(cnt + 64 * u.pm, 1u, __ATOMIC_RELAXED, __HIP_MEMORY_SCOPE_AGENT);
        if (wid == 0) {
            unsigned spins = 0;
            for (;;) {
                if ((unsigned)__builtin_amdgcn_readfirstlane(__hip_atomic_load(cnt + 64 * u.pm, __ATOMIC_RELAXED, __HIP_MEMORY_SCOPE_AGENT)) >= 32u) break;
                if (++spins > (1u << 22)) break;
                __builtin_amdgcn_s_sleep(2);
            }
            __builtin_amdgcn_fence(__ATOMIC_ACQUIRE, "agent");
        }
        asm volatile("s_waitcnt vmcnt(0) lgkmcnt(0)" ::: "memory"); __builtin_amdgcn_s_barrier(); asm volatile("" ::: "memory");
        if (lane < 32) {
            const float* sl = slots + (size_t)(u.pm * BM + row) * 4; float t = 0.f;
#pragma unroll
            for (int q = 0; q < 4; ++q) t += __hip_atomic_load(sl + q, __ATOMIC_RELAXED, __HIP_MEMORY_SCOPE_AGENT);
            S[row] = 1.0f / sqrtf(t * (1.0f / 1024.0f) + 1e-6f);
        }
        asm volatile("s_waitcnt vmcnt(0) lgkmcnt(0)" ::: "memory"); __builtin_amdgcn_s_barrier(); asm volatile("" ::: "memory");
    }
    __device__ __forceinline__ void fused(f32x4 (&acc)[2][2][4][2], const Unit& u, int wr, int wc, int fr, int fq, PG8_LAS unsigned char* lds, int wid, int lane) const {
        const PG8_LAS float* S = (const PG8_LAS float*)(lds + 4096);
        const int col0 = u.pn * BM + wc * 32 + 8 * fq;
        u32x4 pre[2][4][2];
        if (!BASE_F32) {
#pragma unroll
            for (int ai = 0; ai < 2; ++ai)
#pragma unroll
                for (int m = 0; m < 4; ++m)
#pragma unroll
                    for (int bj = 0; bj < 2; ++bj) pre[ai][m][bj] = __builtin_nontemporal_load((const u32x4*)((const bf16_t*)base + (size_t)(u.pm * BM + ai * HALF + wr * 64 + m * 16 + fr) * 1024 + col0 + bj * HALF));
        }
        stats(acc, u, wr, wc, fr, fq, lds, wid, lane, slots1, cnt1);
        f32x4 gv[2][2];
#pragma unroll
        for (int bj = 0; bj < 2; ++bj)
#pragma unroll
            for (int n = 0; n < 2; ++n) gv[bj][n] = *(const f32x4*)(gain + col0 + bj * HALF + n * 4);
#pragma unroll
        for (int ai = 0; ai < 2; ++ai)
#pragma unroll
            for (int m = 0; m < 4; ++m) { const int r = ai * HALF + wr * 64 + m * 16 + fr; const float rs = S[r]; const size_t off = (size_t)(u.pm * BM + r) * 1024 + col0;
                float sq = 0.f;
#pragma unroll
                for (int bj = 0; bj < 2; ++bj) { f32x4 b0, b1;
                    if (BASE_F32) { b0 = __builtin_nontemporal_load((const f32x4*)((const float*)base + off + bj * HALF)); b1 = __builtin_nontemporal_load((const f32x4*)((const float*)base + off + bj * HALF + 4)); }
                    else { const u32x4 bw = pre[ai][m][bj];
                        b0 = (f32x4){__uint_as_float(bw.x << 16), __uint_as_float(bw.x & 0xffff0000u), __uint_as_float(bw.y << 16), __uint_as_float(bw.y & 0xffff0000u)};
                        b1 = (f32x4){__uint_as_float(bw.z << 16), __uint_as_float(bw.z & 0xffff0000u), __uint_as_float(bw.w << 16), __uint_as_float(bw.w & 0xffff0000u)}; }
                    const f32x4 x0 = b0 + acc[ai][bj][m][0] * gv[bj][0] * rs, x1 = b1 + acc[ai][bj][m][1] * gv[bj][1] * rs;
                    if (FINAL) { __builtin_nontemporal_store(x0, (f32x4*)(out + off + bj * HALF)); __builtin_nontemporal_store(x1, (f32x4*)(out + off + bj * HALF + 4)); }
                    else { sq += ((x0[0] * x0[0] + x0[1] * x0[1]) + (x0[2] * x0[2] + x0[3] * x0[3])) + ((x1[0] * x1[0] + x1[1] * x1[1]) + (x1[2] * x1[2] + x1[3] * x1[3]));
                        u32x4 w; w.x = cvt_pk_bf16(x0[0], x0[1]); w.y = cvt_pk_bf16(x0[2], x0[3]); w.z = cvt_pk_bf16(x1[0], x1[1]); w.w = cvt_pk_bf16(x1[2], x1[3]); *(u32x4*)(xb + off + bj * HALF) = w; } }
                if (!FINAL) { sq += __shfl_xor(sq, 16); sq += __shfl_xor(sq, 32); if (fq == 0) ssq[(size_t)(u.pm * BM + r) * 16 + u.pn * 4 + wc] = sq; }
                if ((m & 3) == 3) asm volatile("" ::: "memory"); }
    }
};

template <class Epi, class Sched, bool ALIGN_EPI = false, bool SP2 = false>
__device__ __forceinline__ void gemm_phase(PG8_LAS unsigned char* lds, const Gemm g, const Sched& S, const Epi& E) {
    const int tid = tidx(), wid = __builtin_amdgcn_readfirstlane(tid >> 6), lane = tid & 63, wr = wid >> 2, wc = wid & 3, fr = lane & 15, fq = lane >> 4;
    const int K = g.K, nt = K / BK;
    unsigned voffA[2], voffB[2];
#pragma unroll
    for (int i = 0; i < 2; ++i) { int R, C; stage_rc(tid * 16 + i * 8192, R, C); const int Rb = Epi::PERM ? ((R & ~31) + perm32(R & 31)) : R;
        voffA[i] = (unsigned)(R * K + C) * 2u; voffB[i] = (unsigned)(Rb * K + C) * 2u; }
    const size_t kstep = (size_t)(BK * 2);
    const size_t hstep = (size_t)HALF * K * 2;
    const size_t tstep = 2 * hstep;
    const unsigned ldsw = (unsigned)wid * 1024u;
    const int aoff = lds_byte(wr * 64 + fr, fq * 8), boff = lds_byte(wc * 32 + fr, fq * 8);
#define PG8_SA(b, h) (((b) * 2 + (h)) * HTB)
#define PG8_SB(b, h) ((4 + (b) * 2 + (h)) * HTB)
#define PG8_STAGE(bufoff, gbase, voff) do { _Pragma("unroll") for (int _i = 0; _i < 2; ++_i) \
        __builtin_amdgcn_global_load_lds((const unsigned*)((const char*)(gbase) + (voff)[_i]), (PG8_LAS unsigned*)(lds + (bufoff) + ldsw + _i * 8192), 16, 0, 0); } while (0)
#define PG8_LDA(dst, b, h) do { _Pragma("unroll") for (int m = 0; m < 4; ++m) _Pragma("unroll") for (int k = 0; k < 2; ++k) dst[m][k] = *(const PG8_LAS bf16x8*)(lds + PG8_SA(b, h) + aoff + m * 2048 + k * 1024); } while (0)
#define PG8_LDB(dst, b, h) do { _Pragma("unroll") for (int n = 0; n < 2; ++n) _Pragma("unroll") for (int k = 0; k < 2; ++k) dst[n][k] = *(const PG8_LAS bf16x8*)(lds + PG8_SB(b, h) + boff + n * 2048 + k * 1024); } while (0)
#define PG8_MMA(ai, bj, At, Bt) do { __builtin_amdgcn_s_setprio(1); _Pragma("unroll") for (int m = 0; m < 4; ++m) _Pragma("unroll") for (int n = 0; n < 2; ++n) _Pragma("unroll") for (int k = 0; k < 2; ++k) \
        acc[ai][bj][m][n] = __builtin_amdgcn_mfma_f32_16x16x32_bf16(Bt[n][k], At[m][k], acc[ai][bj][m][n], 0, 0, 0); __builtin_amdgcn_s_setprio(0); } while (0)
#define PG8_WAIT_V(n) asm volatile("s_waitcnt vmcnt(" #n ")" ::: "memory")
#define PG8_WAIT_L(n) asm volatile("s_waitcnt lgkmcnt(" #n ")" ::: "memory")
#define PG8_BAR __builtin_amdgcn_s_barrier()
#define PG8_SCHED __builtin_amdgcn_sched_barrier(0)
    Unit cur, nxt; int ui = 0;
    if (!S.next(0, cur)) return;
    f32x4 acc[2][2][4][2];
#pragma unroll
    for (int a = 0; a < 2; ++a)
#pragma unroll
        for (int b = 0; b < 2; ++b)
#pragma unroll
            for (int m = 0; m < 4; ++m)
#pragma unroll
                for (int n = 0; n < 2; ++n) acc[a][b][m][n] = (f32x4){0.f, 0.f, 0.f, 0.f};
    bf16x8 At[4][2], B0[2][2], B1[2][2];
    const char* cA = (const char*)g.A + (size_t)cur.pm * tstep; const char* cB = (const char*)g.Bt + (size_t)cur.pn * tstep;
    S.a_ready(cur);
    if constexpr (SP2) {
        PG8_STAGE(PG8_SB(0, 0), cB, voffB); PG8_STAGE(PG8_SB(0, 1), cB + hstep, voffB); PG8_STAGE(PG8_SA(0, 0), cA, voffA); PG8_STAGE(PG8_SA(0, 1), cA + hstep, voffA);
        if (wr == 1) PG8_BAR;
        PG8_WAIT_V(2); PG8_BAR;
        PG8_STAGE(PG8_SB(1, 0), cB + kstep, voffB); PG8_STAGE(PG8_SA(1, 0), cA + kstep, voffA); PG8_STAGE(PG8_SB(1, 1), cB + hstep + kstep, voffB);
        PG8_WAIT_V(6); PG8_BAR;
    } else {
        PG8_STAGE(PG8_SB(0, 0), cB, voffB); PG8_STAGE(PG8_SA(0, 0), cA, voffA); PG8_STAGE(PG8_SB(0, 1), cB + hstep, voffB); PG8_STAGE(PG8_SA(0, 1), cA + hstep, voffA);
        if (wr == 1) PG8_BAR;
        PG8_WAIT_V(4); PG8_BAR;
        PG8_STAGE(PG8_SB(1, 0), cB + kstep, voffB); PG8_STAGE(PG8_SA(1, 0), cA + kstep, voffA); PG8_STAGE(PG8_SB(1, 1), cB + hstep + kstep, voffB);
        PG8_WAIT_V(6); PG8_BAR;
    }
    for (;;) {
        const bool has_next = S.next(ui + 1, nxt);
        const char* nA = has_next ? (const char*)g.A + (size_t)nxt.pm * tstep : cA; const char* nB = has_next ? (const char*)g.Bt + (size_t)nxt.pn * tstep : cB;
        for (int t = 0; t < nt; t += 2) {
            const bool last = (t == nt - 2);
            const char* a1 = cA + (size_t)(t + 1) * kstep;
            const char* a2 = last ? nA : cA + (size_t)(t + 2) * kstep; const char* b2 = last ? nB : cB + (size_t)(t + 2) * kstep;
            const char* a3 = a2 + kstep; const char* b3 = b2 + kstep;
            if (last && has_next) S.a_ready(nxt);
            if constexpr (SP2) {
            PG8_LDB(B0, 0, 0); PG8_LDB(B1, 0, 1); PG8_SCHED; PG8_LDA(At, 0, 0); PG8_STAGE(PG8_SA(1, 1), a1 + hstep, voffA);
            PG8_WAIT_V(8); PG8_WAIT_L(0); PG8_BAR; PG8_MMA(0, 0, At, B0); PG8_MMA(0, 1, At, B1); PG8_BAR; PG8_SCHED;
            PG8_LDA(At, 0, 1); PG8_STAGE(PG8_SB(0, 0), b2, voffB); PG8_STAGE(PG8_SB(0, 1), b2 + hstep, voffB); PG8_STAGE(PG8_SA(0, 0), a2, voffA);
            PG8_WAIT_V(8); PG8_WAIT_L(0); PG8_BAR; PG8_MMA(1, 0, At, B0); PG8_MMA(1, 1, At, B1); PG8_BAR; PG8_SCHED;
            PG8_LDB(B0, 1, 0); PG8_LDB(B1, 1, 1); PG8_SCHED; PG8_LDA(At, 1, 0); PG8_STAGE(PG8_SA(0, 1), a2 + hstep, voffA);
            PG8_WAIT_V(8); PG8_WAIT_L(0); PG8_BAR; PG8_MMA(0, 0, At, B0); PG8_MMA(0, 1, At, B1); PG8_BAR; PG8_SCHED;
            PG8_LDA(At, 1, 1); PG8_STAGE(PG8_SB(1, 0), b3, voffB); PG8_STAGE(PG8_SB(1, 1), b3 + hstep, voffB); PG8_STAGE(PG8_SA(1, 0), a3, voffA);
            PG8_WAIT_V(8); PG8_WAIT_L(0); PG8_BAR; PG8_MMA(1, 0, At, B0); PG8_MMA(1, 1, At, B1); PG8_BAR; PG8_SCHED;
            } else {
            PG8_LDB(B0, 0, 0); PG8_SCHED; PG8_LDA(At, 0, 0); PG8_STAGE(PG8_SA(1, 1), a1 + hstep, voffA);
            PG8_WAIT_L(8); PG8_BAR; PG8_WAIT_L(0); PG8_MMA(0, 0, At, B0); PG8_BAR; PG8_SCHED;
            PG8_LDB(B1, 0, 1); PG8_STAGE(PG8_SB(0, 0), b2, voffB);
            PG8_BAR; PG8_WAIT_L(0); PG8_MMA(0, 1, At, B1); PG8_BAR;
            PG8_LDA(At, 0, 1); PG8_STAGE(PG8_SA(0, 0), a2, voffA);
            PG8_BAR; PG8_WAIT_L(0); PG8_MMA(1, 0, At, B0); PG8_BAR; PG8_SCHED;
            PG8_STAGE(PG8_SB(0, 1), b2 + hstep, voffB);
            PG8_WAIT_V(6); PG8_BAR; PG8_MMA(1, 1, At, B1); PG8_BAR;
            PG8_LDB(B0, 1, 0); PG8_SCHED; PG8_LDA(At, 1, 0); PG8_STAGE(PG8_SA(0, 1), a2 + hstep, voffA);
            PG8_WAIT_L(8); PG8_BAR; PG8_WAIT_L(0); PG8_MMA(0, 0, At, B0); PG8_BAR; PG8_SCHED;
            PG8_LDB(B1, 1, 1); PG8_STAGE(PG8_SB(1, 0), b3, voffB);
            PG8_BAR; PG8_WAIT_L(0); PG8_MMA(0, 1, At, B1); PG8_BAR;
            PG8_LDA(At, 1, 1); PG8_STAGE(PG8_SA(1, 0), a3, voffA);
            PG8_BAR; PG8_WAIT_L(0); PG8_MMA(1, 0, At, B0); PG8_BAR; PG8_SCHED;
            PG8_STAGE(PG8_SB(1, 1), b3 + hstep, voffB);
            PG8_WAIT_V(6); PG8_BAR; PG8_MMA(1, 1, At, B1); PG8_BAR;
            }
        }
        if constexpr (ALIGN_EPI) { if (wr == 0) PG8_BAR; }
        if constexpr (!Epi::AFTER_DRAIN) { E(acc, cur, wr, wc, fr, fq); S.done(cur); }
        if (!has_next) break;
#pragma unroll
        for (int a = 0; a < 2; ++a)
#pragma unroll
            for (int b = 0; b < 2; ++b)
#pragma unroll
                for (int m = 0; m < 4; ++m)
#pragma unroll
                    for (int n = 0; n < 2; ++n) acc[a][b][m][n] = (f32x4){0.f, 0.f, 0.f, 0.f};
        cur = nxt; cA = nA; cB = nB; ++ui;
        if constexpr (ALIGN_EPI) { if (wr == 1) PG8_BAR; }
    }
    PG8_WAIT_V(0);
    if constexpr (!ALIGN_EPI) { if (wr == 0) PG8_BAR; }
    PG8_BAR;
    if constexpr (Epi::AFTER_DRAIN) { E.fused(acc, cur, wr, wc, fr, fq, lds, wid, lane); S.done(cur); }
#undef PG8_SA
#undef PG8_SB
#undef PG8_STAGE
#undef PG8_LDA
#undef PG8_LDB
#undef PG8_MMA
#undef PG8_WAIT_V
#undef PG8_WAIT_L
#undef PG8_BAR
#undef PG8_SCHED
}
}

using pg8::bf16_t; using pg8::bf16x8; using pg8::f32x4; using pg8::u32x4; using pg8::u32x2; using pg8::pk2;
typedef float f32x16 __attribute__((ext_vector_type(16)));
typedef float f32x2v __attribute__((ext_vector_type(2)));
typedef short s16x4v __attribute__((ext_vector_type(4)));
#define LAS3 __attribute__((address_space(3)))
typedef short s16x8 __attribute__((ext_vector_type(8)));
constexpr int DM = 1024, MP = 16384, MS = 128, MT = MP + MS, SEQ = 4096, NB = 4, DB = 8, DS = 16, PAST = 2048, LKS = 2112  , NKS = 64  , FF = 4096, NMEM = 256;
constexpr float LOG2E = 1.4426950408889634f;
constexpr float CFOX = 0.125f * LOG2E, CMEM = 0.08838834764831845f * LOG2E;
constexpr int NTHR = 512;
constexpr int LDS_BYTES = 147456, RING_BYTES = 131072, MISC_OFF = LDS_BYTES - 256;

constexpr size_t O_Y = 0, O_YS = 16777216, O_PSP = 16908288, O_PSS = 16939008, O_KP = 17000448, O_VP = 25389056, O_LFP = 33777664, O_KS = 33908736, O_VS = 33974272, O_LFS = 34039808, O_MK = 34040832, O_MV = 35089408;

constexpr size_t MiB = 1u << 20;
constexpr size_t WS_CTL = 0, CTL_BYTES = 1 * MiB;
constexpr size_t WS_SLOTS = 1 * MiB;
constexpr size_t SLOT_BANK = 69632;
constexpr size_t WS_WIN0 = 4 * MiB;
constexpr size_t WS_WINKV = 6 * MiB;
constexpr size_t WS_WOUT = 10 * MiB;
constexpr size_t WS_WUP = 14 * MiB;
constexpr size_t WS_WDN = 30 * MiB;
constexpr size_t WS_WMEM = 46 * MiB;
constexpr size_t WS_WPOOL = 50 * MiB;
constexpr size_t WS_WF = 50 * MiB + 512 * 1024;
constexpr size_t WS_MN = 51 * MiB;
constexpr size_t WS_MKVP = 53 * MiB;
constexpr size_t WS_MKS = 57 * MiB;
constexpr size_t WS_MVS = 61 * MiB;
constexpr size_t WS_XN = 65 * MiB;
constexpr size_t WS_OV = 100 * MiB;
constexpr size_t WS_HB = WS_OV;
constexpr size_t WS_MI = WS_OV;
constexpr size_t WS_MQ = WS_OV + 17 * MiB;
constexpr size_t WS_CAT = WS_OV + 34 * MiB;
constexpr size_t WS_KB = WS_OV + 67 * MiB;
constexpr size_t WS_VB = WS_OV + 84 * MiB;
constexpr size_t WS_KSB = WS_OV + 101 * MiB;
constexpr size_t WS_VSB = WS_OV + 118 * MiB;
constexpr size_t WS_SSQ = WS_OV + 135 * MiB;
constexpr size_t WS_END = WS_SSQ + 2 * MiB;
static_assert((size_t)MT * FF * 2 <= 135 * MiB, "HB fits");
constexpr int CW_Q = 64;
constexpr int CW_CNT = 1024;
constexpr int CW_BAR = 65536;

struct Params { const float* in[24]; float* out; unsigned char* ws; int ph_lo, ph_hi; };

#define MFMA32(a, b, c) __builtin_amdgcn_mfma_f32_32x32x16_bf16((a), (b), (c), 0, 0, 0)
__device__ __forceinline__ int crow(int r, int h) { return (r & 3) + 8 * (r >> 2) + 4 * h; }
__device__ __forceinline__ float bf2f(unsigned short u) { return __uint_as_float((unsigned)u << 16); }
__device__ __forceinline__ unsigned short f2bf(float f) { return (unsigned short)(pk2(f, 0.f) & 0xffffu); }
__device__ __forceinline__ size_t foff(int row, int k, int K) { return ((((size_t)(row >> 5) * (K >> 4) + (k >> 4)) * 64 + ((k >> 3) & 1) * 32 + (row & 31)) << 3) + (k & 7); }
__device__ __forceinline__ float wave_sum(float v) {
#pragma unroll
    for (int o = 1; o < 64; o <<= 1) v += __shfl_xor(v, o);
    return v;
}

__device__ __forceinline__ void transpose_item(const float* W, int K, int N, int ldw, const float* gain, bf16_t* WT, float* scr, int item, int lane) {
    const int nblk = N / 64, kb = item / nblk, nb = item % nblk, k0 = 64 * kb, n0 = 64 * nb;
    const int lr = lane >> 4, lc = 4 * (lane & 15);
    f32x4 v[16];
#pragma unroll
    for (int i = 0; i < 16; ++i) v[i] = __builtin_nontemporal_load((const f32x4*)(W + (size_t)(k0 + 4 * i + lr) * ldw + n0 + lc));
#pragma unroll
    for (int i = 0; i < 16; ++i) { const int kk = 4 * i + lr; const float gk = gain ? gain[k0 + kk] : 1.f; float* d = scr + kk * 65 + lc; d[0] = v[i].x * gk; d[1] = v[i].y * gk; d[2] = v[i].z * gk; d[3] = v[i].w * gk; }
    asm volatile("s_waitcnt lgkmcnt(0)" ::: "memory");
    const int c = lane & 7;
#pragma unroll
    for (int j = 0; j < 8; ++j) { const int n = (lane >> 3) + 8 * j; const float* s = scr + (8 * c) * 65 + n;
        u32x4 o; o.x = pk2(s[0 * 65], s[1 * 65]); o.y = pk2(s[2 * 65], s[3 * 65]); o.z = pk2(s[4 * 65], s[5 * 65]); o.w = pk2(s[6 * 65], s[7 * 65]);
        *(u32x4*)(WT + (size_t)(n0 + n) * K + k0 + 8 * c) = o; }
    asm volatile("s_waitcnt lgkmcnt(0)" ::: "memory");
}
__device__ __forceinline__ void norm_row_to_bf16(const float* xrow, bf16_t* orow, int lane, int frow = -1) {
    const f32x4* xr = (const f32x4*)xrow + lane;
    f32x4 v[4]; float s = 0.f;
#pragma unroll
    for (int j = 0; j < 4; ++j) { v[j] = __builtin_nontemporal_load(xr + 64 * j); s += (v[j].x * v[j].x + v[j].y * v[j].y) + (v[j].z * v[j].z + v[j].w * v[j].w); }
    const float rs = 1.f / sqrtf(wave_sum(s) * (1.f / 1024.f) + 1e-6f);
    u32x2* o8 = (u32x2*)orow + lane;
#pragma unroll
    for (int j = 0; j < 4; ++j) { u32x2 w; w.x = pk2(v[j].x * rs, v[j].y * rs); w.y = pk2(v[j].z * rs, v[j].w * rs);
        if (frow < 0) o8[64 * j] = w; else *(u32x2*)(orow + foff(frow, 256 * j + 4 * lane, 1024)) = w; }
}
__device__ __forceinline__ void cvt_rows(const float* src, bf16_t* dst, size_t nchunks  , int chunks_per_row, int rpb, int dpb, size_t gtid, size_t gn) {
    for (size_t c = gtid; c < nchunks; c += gn) {
        const size_t r = c / chunks_per_row; const int cc = (int)(c % chunks_per_row);
        const size_t dr = (r / rpb) * dpb + (r % rpb);
        const f32x4 a = __builtin_nontemporal_load((const f32x4*)(src + c * 8)), b = __builtin_nontemporal_load((const f32x4*)(src + c * 8 + 4));
        u32x4 w; w.x = pk2(a.x, a.y); w.y = pk2(a.z, a.w); w.z = pk2(b.x, b.y); w.w = pk2(b.z, b.w);
        *(u32x4*)(dst + (dr * chunks_per_row + cc) * 8) = w;
    }
}

template <bool AFRAG = true>
__device__ __forceinline__ void skinny_gemm(const bf16_t* A, const bf16_t* Bt, int K_, int row0, int col0, float* red, f32x4 (&o)[2]) {
    const int tid = tidx(), w = tid >> 6, lane = tid & 63, r32 = lane & 31, h = lane >> 5, kg = w & 3, rh = w >> 2;
    int K = K_; asm volatile("" : "+s"(K));
    const int nch = K >> 10;
    unsigned char* Bs = (unsigned char*)red;
    const bf16x8* ap = (const bf16x8*)A + ((size_t)((row0 >> 5) + 2 * rh) * (K >> 4) + 16 * kg) * 64 + lane;
    const size_t rbs = (size_t)(K >> 4) * 64;
    const bf16_t* apr = A + (size_t)(row0 + 64 * rh + r32) * K + 256 * kg + 8 * h;
    f32x16 acc[2];
#pragma unroll
    for (int i = 0; i < 2; ++i)
#pragma unroll
        for (int r = 0; r < 16; ++r) acc[i][r] = 0.f;
    u32x4 br[8];
#define SK_BLOAD(ch) do { _Pragma("unroll") for (int i_ = 0; i_ < 8; ++i_) { const int idx_ = tid + NTHR * i_; br[i_] = *(const u32x4*)(Bt + (size_t)(col0 + (idx_ >> 7)) * K + (ch) * 1024 + (idx_ & 127) * 8); } } while (0)
#define SK_ALOAD(dst, ch, hf) do { _Pragma("unroll") for (int ks_ = 0; ks_ < 8; ++ks_) _Pragma("unroll") for (int rb_ = 0; rb_ < 2; ++rb_) \
        dst[ks_][rb_] = AFRAG ? ap[rb_ * rbs + (size_t)((ch) * 64 + (hf) * 8 + ks_) * 64] : *(const bf16x8*)(apr + (size_t)rb_ * 32 * K + (ch) * 1024 + (hf) * 128 + 16 * ks_); } while (0)
#define SK_COMP(src, hf) do { _Pragma("unroll") for (int ks_ = 0; ks_ < 8; ++ks_) { const bf16x8 b_ = *(const bf16x8*)(Bs + r32 * 2064 + (256 * kg + (hf) * 128 + 16 * ks_ + 8 * h) * 2); \
        _Pragma("unroll") for (int rb_ = 0; rb_ < 2; ++rb_) acc[rb_] = MFMA32(b_, src[ks_][rb_], acc[rb_]); } } while (0)
    bf16x8 a0[8][2];
    SK_BLOAD(0);
#pragma nounroll
    for (int ch = 0; ch < nch; ++ch) {
        SK_ALOAD(a0, ch, 0);
        __syncthreads();
#pragma unroll
        for (int i = 0; i < 8; ++i) { const int idx = tid + NTHR * i; *(u32x4*)(Bs + (idx >> 7) * 2064 + (idx & 127) * 16) = br[i]; }
        __syncthreads();
        if (ch + 1 < nch) SK_BLOAD(ch + 1);
        SK_COMP(a0, 0);
        SK_ALOAD(a0, ch, 1);
        SK_COMP(a0, 1);
    }
#undef SK_BLOAD
#undef SK_ALOAD
#undef SK_COMP
    __syncthreads();
#pragma unroll
    for (int rb = 0; rb < 2; ++rb)
#pragma unroll
        for (int r = 0; r < 16; ++r) red[((kg * 4 + 2 * rh + rb) * 16 + r) * 64 + lane] = acc[rb][r];
    __syncthreads();
    const int rbo = w >> 1, rbase = 8 * (w & 1);
    float v[8];
#pragma unroll
    for (int i = 0; i < 8; ++i) { float s = 0.f;
#pragma unroll
        for (int q = 0; q < 4; ++q) s += red[((q * 4 + rbo) * 16 + rbase + i) * 64 + lane];
        v[i] = s; }
    o[0] = (f32x4){v[0], v[1], v[2], v[3]}; o[1] = (f32x4){v[4], v[5], v[6], v[7]};
    __syncthreads();
}
__device__ __forceinline__ void skinny_rowsum(float s, float* tmp  , float* part  ) {
    const int tid = tidx(), w = tid >> 6, lane = tid & 63, r32 = lane & 31, h = lane >> 5;
    s += __shfl_xor(s, 32);
    if (h == 0) tmp[(w & 1) * 128 + 32 * (w >> 1) + r32] = s;
    __syncthreads();
    if (tid < 128) part[tid] = tmp[tid] + tmp[128 + tid];
    __syncthreads();
}
__device__ __forceinline__ void row_exchange(float* slots  , unsigned* cnt, int nparts, int part, int rows, const float* partL, float* totL) {
    const int tid = tidx(), lane = tid & 63, wid = tid >> 6;
    if (tid < rows) __hip_atomic_store(slots + (size_t)tid * nparts + part, partL[tid], __ATOMIC_RELAXED, __HIP_MEMORY_SCOPE_AGENT);
    asm volatile("s_waitcnt vmcnt(0)" ::: "memory");
    if (lane == 0) __hip_atomic_fetch_add(cnt, 1u, __ATOMIC_RELAXED, __HIP_MEMORY_SCOPE_AGENT);
    if (wid == 0) {
        unsigned spins = 0; const unsigned want = 8u * (unsigned)nparts;
        for (;;) {
            if ((unsigned)__builtin_amdgcn_readfirstlane(__hip_atomic_load(cnt, __ATOMIC_RELAXED, __HIP_MEMORY_SCOPE_AGENT)) >= want) break;
            if (++spins > (1u << 22)) break;
            __builtin_amdgcn_s_sleep(2);
        }
        __builtin_amdgcn_fence(__ATOMIC_ACQUIRE, "agent");
    }
    asm volatile("s_waitcnt vmcnt(0) lgkmcnt(0)" ::: "memory");
    __syncthreads();
    if (tid < rows) { float t = 0.f; for (int q = 0; q < nparts; ++q) t += __hip_atomic_load(slots + (size_t)tid * nparts + q, __ATOMIC_RELAXED, __HIP_MEMORY_SCOPE_AGENT); totL[tid] = t; }
    __syncthreads();
}
__device__ __forceinline__ void skinny_norm(f32x4 (&o)[2], int part, const float* base, float* out, bf16_t* xn, float* ssq_s, const float* gain, float* slots1, unsigned* cnt1, float* ldsf) {
    const int tid = tidx(), w = tid >> 6, lane = tid & 63, r32 = lane & 31, h = lane >> 5;
    float* tmp = ldsf; float* partL = ldsf + 256; float* totL = ldsf + 384;
    const int row = 32 * (w >> 1) + r32; const int c0 = part * 32 + 16 * (w & 1) + 4 * h;
    float s = 0.f;
#pragma unroll
    for (int g = 0; g < 2; ++g) s += (o[g].x * o[g].x + o[g].y * o[g].y) + (o[g].z * o[g].z + o[g].w * o[g].w);
    skinny_rowsum(s, tmp, partL);
    row_exchange(slots1, cnt1, 32, part, 128, partL, totL);
    const float rs1 = 1.0f / sqrtf(totL[row] * (1.0f / 1024.0f) + 1e-6f);
    f32x4 x1[2]; float s2 = 0.f;
#pragma unroll
    for (int g = 0; g < 2; ++g) { const int c = c0 + 8 * g; const f32x4 gv = *(const f32x4*)(gain + c); const f32x4 bs = *(const f32x4*)(base + (size_t)row * 1024 + c); x1[g] = bs + o[g] * gv * rs1;
        s2 += (x1[g].x * x1[g].x + x1[g].y * x1[g].y) + (x1[g].z * x1[g].z + x1[g].w * x1[g].w);
        *(f32x4*)(out + (size_t)row * 1024 + c) = x1[g];
        if (xn) { u32x2 wv; wv.x = pk2(x1[g].x, x1[g].y); wv.y = pk2(x1[g].z, x1[g].w); *(u32x2*)(xn + foff(row, c, 1024)) = wv; } }
    if (xn) { __syncthreads(); skinny_rowsum(s2, tmp, partL); if (tid < 128) ssq_s[tid * 32 + part] = partL[tid]; }
    __syncthreads();
}
__device__ __forceinline__ float sample_rs(const float* ssq_s, int row) {
    const f32x4* q = (const f32x4*)(ssq_s + row * 32); float t = 0.f;
#pragma unroll
    for (int i = 0; i < 8; ++i) { const f32x4 v = q[i]; t += (v.x + v.y) + (v.z + v.w); }
    return 1.0f / sqrtf(t * (1.0f / 1024.0f) + 1e-6f);
}
__device__ __forceinline__ void panel_rs(const float* ssq, int pm, float* rsL) {
    const int tid = tidx();
    if (tid < 256) { const f32x4* q = (const f32x4*)(ssq + (size_t)(pm * 256 + tid) * 16); float t = 0.f;
#pragma unroll
        for (int i = 0; i < 4; ++i) { const f32x4 v = q[i]; t += (v.x + v.y) + (v.z + v.w); }
        rsL[tid] = 1.0f / sqrtf(t * (1.0f / 1024.0f) + 1e-6f); }
    __syncthreads();
}

__device__ __forceinline__ int vpos(int row) { return (row & ~12) | ((row & 4) << 1) | ((row & 8) >> 1); }
__device__ __forceinline__ void fox_bias(float* biasL, float* wsum, const float* s1, int n1, const float* s2, int n, int npad);
template <int HD, bool FOX, bool F32KV = false>
__device__ __forceinline__ void attn_unit(unsigned char* lds, const bf16_t* Q, int ldq, int nq_valid, const bf16_t* Kp, const bf16_t* Vp, int ldk, int n_keys, int qpos0,
                                          const float* biasL, bf16_t* O, int ldo, const float* Kf = nullptr, const float* Vf = nullptr, int nf32 = 0, int frow0 = -1, int fcol0 = 0,
                                          const float* fb_s1 = nullptr, int fb_n1 = 0, const float* fb_s2 = nullptr, int fb_npad = 0, float* fb_wsum = nullptr) {
    constexpr int KT = (HD == 64 && !F32KV) ? 128 : 64, NTT = KT / 32, NKS = KT / 16;
    constexpr int KP = HD * 2 + 16, VP = HD * 2 + 64, KBY = KT * KP, VBY = KT * VP, BUF = KBY + VBY;
    constexpr int CH = HD / 8, NL = (KT * CH) / NTHR, ND = HD / 16, NO = HD / 32; constexpr bool DEEP = (HD == 64) && !F32KV && (KT == 64);
    const int tid = tidx(), w = __builtin_amdgcn_readfirstlane(tid >> 6), lane = tid & 63, r32 = lane & 31, h = lane >> 5;
    int qrow = 32 * w + r32; if (qrow >= nq_valid) qrow = nq_valid - 1;
    bf16x8 qf[ND];
#pragma unroll
    for (int d0 = 0; d0 < ND; ++d0) qf[d0] = *(const bf16x8*)(Q + (size_t)qrow * ldq + 16 * d0 + 8 * h);
    const bool wave_active = (32 * w < nq_valid);
    const int qpos = qpos0 + 32 * w + r32;
    f32x16 o[NO];
#pragma unroll
    for (int i = 0; i < NO; ++i)
#pragma unroll
        for (int r = 0; r < 16; ++r) o[i][r] = 0.f;
    float m_run = -1e30f, l_run = 0.f;
    const int NT = (n_keys + KT - 1) / KT;
    u32x4 krA[NL], vrA[NL], krB[NL], vrB[NL]; f32x4 kraw[2], vraw[2];
#define ATT_GLOAD(t, kr, vr) do { if (F32KV && (t) < nf32) { const int row_ = tid / CH, ch_ = tid % CH; const size_t go_ = (size_t)((t) * 64 + row_) * 512 + ch_ * 8; \
        kraw[0] = __builtin_nontemporal_load((const f32x4*)(Kf + go_)); kraw[1] = __builtin_nontemporal_load((const f32x4*)(Kf + go_ + 4)); vraw[0] = __builtin_nontemporal_load((const f32x4*)(Vf + go_)); vraw[1] = __builtin_nontemporal_load((const f32x4*)(Vf + go_ + 4)); } else { \
        _Pragma("unroll") for (int i_ = 0; i_ < NL; ++i_) { const int idx_ = tid + NTHR * i_, row_ = idx_ / CH, ch_ = idx_ % CH; const size_t go_ = (size_t)(((t) - nf32) * KT + row_) * ldk + ch_ * 8; \
        kr[i_] = *(const u32x4*)(Kp + go_); vr[i_] = *(const u32x4*)(Vp + go_); } } } while (0)
#define ATT_LWRITE(buf, t, kr, vr) do { if (F32KV && (t) < nf32) { kr[0].x = pk2(kraw[0].x, kraw[0].y); kr[0].y = pk2(kraw[0].z, kraw[0].w); kr[0].z = pk2(kraw[1].x, kraw[1].y); kr[0].w = pk2(kraw[1].z, kraw[1].w); \
        vr[0].x = pk2(vraw[0].x, vraw[0].y); vr[0].y = pk2(vraw[0].z, vraw[0].w); vr[0].z = pk2(vraw[1].x, vraw[1].y); vr[0].w = pk2(vraw[1].z, vraw[1].w); } \
        unsigned char* kb_ = lds + (buf) * BUF; unsigned char* vb_ = kb_ + KBY; _Pragma("unroll") for (int i_ = 0; i_ < NL; ++i_) { const int idx_ = tid + NTHR * i_, row_ = idx_ / CH, ch_ = idx_ % CH; \
        *(u32x4*)(kb_ + row_ * KP + ch_ * 16) = kr[i_]; *(u32x4*)(vb_ + row_ * VP + ch_ * 16) = vr[i_]; } } while (0)
#define ATT_COMPUTE(TT_) do { const int t = (TT_); \
        const bool doit = wave_active && (!FOX || (t * KT <= qpos0 + 32 * w + 31)); \
        if (doit) { \
            const unsigned char* Kb = lds + (t & 1) * BUF; const unsigned char* Vb = Kb + KBY; \
            f32x16 p[NTT]; \
_Pragma("unroll") \
            for (int tt = 0; tt < NTT; ++tt) { \
                f32x16 c; \
                if (FOX) { \
_Pragma("unroll") \
                    for (int g = 0; g < 4; ++g) { const f32x4 bv = *(const f32x4*)(biasL + t * KT + 32 * tt + 8 * g + 4 * h); c[4 * g] = bv.x; c[4 * g + 1] = bv.y; c[4 * g + 2] = bv.z; c[4 * g + 3] = bv.w; } \
                } else { \
_Pragma("unroll") \
                    for (int r = 0; r < 16; ++r) c[r] = 0.f; \
                } \
_Pragma("unroll") \
                for (int d0 = 0; d0 < ND; ++d0) { const bf16x8 a = *(const bf16x8*)(Kb + (32 * tt + r32) * KP + (16 * d0 + 8 * h) * 2); c = MFMA32(a, qf[d0], c); } \
                p[tt] = c; \
            } \
            if (FOX && (t * KT + KT - 1 > qpos0 + 32 * w)) { \
                const int qrel = qpos - t * KT - 4 * h; \
_Pragma("unroll") \
                for (int tt = 0; tt < NTT; ++tt) \
_Pragma("unroll") \
                    for (int r = 0; r < 16; ++r) { if (32 * tt + (r & 3) + 8 * (r >> 2) > qrel) p[tt][r] = -__builtin_inff(); } \
            } \
            float mx = 0.f; \
_Pragma("unroll") \
            for (int tt = 0; tt < NTT; ++tt) { float ma = fmaxf(fmaxf(p[tt][0], p[tt][1]), p[tt][2]); \
_Pragma("unroll") \
                for (int r = 3; r < 15; r += 2) ma = fmaxf(fmaxf(ma, p[tt][r]), p[tt][r + 1]); \
                ma = fmaxf(ma, p[tt][15]); mx = tt == 0 ? ma : fmaxf(mx, ma); } \
            { auto rr = __builtin_amdgcn_permlane32_swap(__float_as_uint(mx), __float_as_uint(mx), false, false); mx = fmaxf(__uint_as_float(rr[0]), __uint_as_float(rr[1])); } \
            if (__any(mx > m_run + 20.0f)) { \
                const float mnew = fmaxf(m_run, mx); const float alpha = __builtin_amdgcn_exp2f(m_run - mnew); \
                l_run *= alpha; m_run = mnew; \
_Pragma("unroll") \
                for (int i = 0; i < NO; ++i) o[i] = o[i] * alpha; \
            } \
            f32x2v ls2 = (f32x2v){0.f, 0.f}; const f32x2v nm2 = (f32x2v){-m_run, -m_run}; \
_Pragma("unroll") \
            for (int tt = 0; tt < NTT; ++tt) \
_Pragma("unroll") \
                for (int r = 0; r < 16; r += 2) { f32x2v x = (f32x2v){p[tt][r], p[tt][r + 1]} + nm2; x.x = __builtin_amdgcn_exp2f(x.x); x.y = __builtin_amdgcn_exp2f(x.y); p[tt][r] = x.x; p[tt][r + 1] = x.y; ls2 += x; } \
            l_run += ls2.x + ls2.y; \
_Pragma("unroll") \
            for (int ks = 0; ks < NKS; ++ks) { \
                const int tt = ks >> 1, s = ks & 1; \
                u32x4 pw; pw.x = pk2(p[tt][8 * s + 0], p[tt][8 * s + 1]); pw.y = pk2(p[tt][8 * s + 2], p[tt][8 * s + 3]); pw.z = pk2(p[tt][8 * s + 4], p[tt][8 * s + 5]); pw.w = pk2(p[tt][8 * s + 6], p[tt][8 * s + 7]); \
                const bf16x8 pb = __builtin_bit_cast(bf16x8, pw); \
_Pragma("unroll") \
                for (int db = 0; db < NO; ++db) { \
                    const LAS3 unsigned char* vp = (const LAS3 unsigned char*)Vb + (32 * tt + 16 * s + 4 * h + ((lane & 15) >> 2)) * VP + 64 * db + 8 * (4 * ((lane >> 4) & 1) + (lane & 3)); \
                    const s16x4v lo = __builtin_amdgcn_ds_read_tr16_b64_v4i16((LAS3 s16x4v*)vp), hi = __builtin_amdgcn_ds_read_tr16_b64_v4i16((LAS3 s16x4v*)(vp + 8 * VP)); \
                    const bf16x8 av = (bf16x8){lo[0], lo[1], lo[2], lo[3], hi[0], hi[1], hi[2], hi[3]}; \
                    o[db] = MFMA32(av, pb, o[db]); \
                } \
            } \
        } \
    } while (0)
    ATT_GLOAD(0, krA, vrA);
    if (FOX) fox_bias((float*)biasL, fb_wsum, fb_s1, fb_n1, fb_s2, n_keys, fb_npad);
    __syncthreads();
    ATT_LWRITE(0, 0, krA, vrA);
    __syncthreads();
    if (DEEP) {
        if (1 < NT) ATT_GLOAD(1, krA, vrA);
        for (int tl = 0; tl < NT; tl += 2) {
            if (tl + 2 < NT) ATT_GLOAD(tl + 2, krB, vrB);
            ATT_COMPUTE(tl);
            if (tl + 1 < NT) ATT_LWRITE((tl + 1) & 1, tl + 1, krA, vrA);
            __syncthreads();
            if (tl + 1 < NT) {
                if (tl + 3 < NT) ATT_GLOAD(tl + 3, krA, vrA);
                ATT_COMPUTE(tl + 1);
                if (tl + 2 < NT) ATT_LWRITE(tl & 1, tl + 2, krB, vrB);
                __syncthreads();
            }
        }
    } else {
        for (int tl = 0; tl < NT; ++tl) {
            if (tl + 1 < NT) ATT_GLOAD(tl + 1, krA, vrA);
            ATT_COMPUTE(tl);
            if (tl + 1 < NT) ATT_LWRITE((tl + 1) & 1, tl + 1, krA, vrA);
            __syncthreads();
        }
    }
#undef ATT_COMPUTE
#undef ATT_GLOAD
#undef ATT_LWRITE
    const float lt = l_run + __shfl_xor(l_run, 32);
    const float inv = 1.0f / lt;
    if (32 * w + r32 < nq_valid) {
        bf16_t* op = O + (size_t)(32 * w + r32) * ldo;
#pragma unroll
        for (int db = 0; db < NO; ++db)
#pragma unroll
            for (int g = 0; g < 4; ++g) { u32x2 wv; wv.x = pk2(o[db][4 * g] * inv, o[db][4 * g + 1] * inv); wv.y = pk2(o[db][4 * g + 2] * inv, o[db][4 * g + 3] * inv);
                if (frow0 < 0) *(u32x2*)(op + 32 * db + 8 * g + 4 * h) = wv; else *(u32x2*)(O + foff(frow0 + 32 * w + r32, fcol0 + 32 * db + 8 * g + 4 * h, 1024)) = wv; }
    }
}

__device__ __forceinline__ void fox_bias(float* biasL, float* wsum  , const float* s1, int n1, const float* s2, int n, int npad) {
    const int tid = tidx(), lane = tid & 63, w = tid >> 6;
    float v[9]; float run = 0.f;
#pragma unroll
    for (int i = 0; i < 9; ++i) { const int p = tid * 9 + i; float x = 0.f; if (p < n) x = (p < n1) ? s1[(size_t)p * 8] : s2[(size_t)(p - n1) * 8]; run += x; v[i] = run; }
    float incl = run;
#pragma unroll
    for (int off = 1; off < 64; off <<= 1) { const float y = __shfl_up(incl, off); if (lane >= off) incl += y; }
    if (lane == 63) wsum[w] = incl;
    __syncthreads();
    float base = incl - run;
    for (int ww = 0; ww < w; ++ww) base += wsum[ww];
#pragma unroll
    for (int i = 0; i < 9; ++i) { const int p = tid * 9 + i; if (p < npad) biasL[p] = (p < n) ? -(base + v[i]) * LOG2E : 0.f; }
    __syncthreads();
}

__device__ __forceinline__ void pool_unit(unsigned char* lds, const Params& p, int unit) {
    const int tid = tidx(), w = tid >> 6, lane = tid & 63, r32 = lane & 31, h = lane >> 5;
    constexpr int XP = 272;
    unsigned char* X = lds; unsigned char* Ap = lds + 144 * XP;
    const bf16_t* MI = (const bf16_t*)(p.ws + WS_MI); bf16_t* CAT = (bf16_t*)(p.ws + WS_CAT); const bf16_t* WpT = (const bf16_t*)(p.ws + WS_WPOOL);
    const float* scale = p.in[16];
    int g, b, t0, nrows, rowbase; bool sample;
    if (unit < 512) { const int tile = unit >> 2; g = unit & 3; b = tile >> 5; t0 = (tile & 31) * 128; nrows = 128; rowbase = b * SEQ; sample = false; }
    else { const int s = unit - 512; b = s >> 2; g = s & 3; t0 = 0; nrows = 16; rowbase = MP + b * DS; sample = true; }
    const int win = 2 << g;
    for (int idx = tid; idx < (15 + nrows) * 16; idx += NTHR) {
        const int j = idx >> 4, ch = idx & 15; const int t = t0 - 15 + j; u32x4 v = (u32x4){0u, 0u, 0u, 0u};
        if (!sample) { if (t >= 0) v = *(const u32x4*)(MI + (size_t)(rowbase + t) * 512 + g * 128 + ch * 8); }
        else if (j < 15) { const float* cp = p.in[2] + ((size_t)(b * 15 + j) * 512 + g * 128 + ch * 8); const f32x4 a = *(const f32x4*)cp, c = *(const f32x4*)(cp + 4);
            v.x = pk2(a.x, a.y); v.y = pk2(a.z, a.w); v.z = pk2(c.x, c.y); v.w = pk2(c.z, c.w); }
        else v = *(const u32x4*)(MI + (size_t)(rowbase + (j - 15)) * 512 + g * 128 + ch * 8);
        *(u32x4*)(X + j * XP + ch * 16) = v;
    }
    __syncthreads();
    if (sample) { for (int idx = tid; idx < 15 * 128; idx += NTHR) { const int i = idx >> 7, c = idx & 127; p.out[O_PSS + (size_t)(b * 15 + i) * 512 + g * 128 + c] = bf2f(*(const unsigned short*)(X + (16 + i) * XP + c * 2)); } }
    else if (t0 == SEQ - 128) { for (int idx = tid; idx < 15 * 128; idx += NTHR) { const int i = idx >> 7, c = idx & 127; p.out[O_PSP + (size_t)(b * 15 + i) * 512 + g * 128 + c] = bf2f(*(const unsigned short*)(X + (128 + i) * XP + c * 2)); } }
    {
        const int c = tid & 127, r0 = (tid >> 7) * 32;
        if (r0 < nrows) {
            const int nr = (nrows - r0) < 32 ? (nrows - r0) : 32;
            float s = 0.f;
            for (int j = 1; j < win; ++j) s += bf2f(*(const unsigned short*)(X + (15 + r0 - j) * XP + c * 2));
            for (int t = r0; t < r0 + nr; ++t) {
                const float xv = bf2f(*(const unsigned short*)(X + (15 + t) * XP + c * 2)); s += xv;
                int cnt = win; if (!sample) { const int ta = t0 + t + 1; cnt = ta < win ? ta : win; }
                const float pooled = s / (float)cnt - xv;
                *(unsigned short*)(Ap + t * XP + c * 2) = f2bf(pooled);
                s -= bf2f(*(const unsigned short*)(X + (15 + t - (win - 1)) * XP + c * 2));
            }
        }
    }
    __syncthreads();
    {
        const int tb = w & 3, dh = w >> 2;
        if (32 * tb < nrows) {
            f32x16 acc[2];
#pragma unroll
            for (int i = 0; i < 2; ++i)
#pragma unroll
                for (int r = 0; r < 16; ++r) acc[i][r] = 0.f;
#pragma unroll
            for (int ks = 0; ks < 8; ++ks) {
                const bf16x8 bfr = *(const bf16x8*)(Ap + (32 * tb + r32) * XP + (16 * ks + 8 * h) * 2);
#pragma unroll
                for (int db = 0; db < 2; ++db) { const bf16x8 a = *(const bf16x8*)(WpT + ((size_t)(g * 128 + 64 * dh + 32 * db + r32) * 128 + 16 * ks + 8 * h)); acc[db] = MFMA32(a, bfr, acc[db]); }
            }
            const int t = 32 * tb + r32;
            if (t < nrows) {
                bf16_t* op = CAT + (size_t)(rowbase + t0 + t) * 1024 + g * 128; bf16_t* opf = CAT + (size_t)MP * 1024;
#pragma unroll
                for (int db = 0; db < 2; ++db)
#pragma unroll
                    for (int q = 0; q < 4; ++q) { const int d = 64 * dh + 32 * db + 8 * q + 4 * h; const f32x4 sc = *(const f32x4*)(scale + g * 128 + d);
                        u32x2 wv; wv.x = pk2(acc[db][4 * q] * sc.x, acc[db][4 * q + 1] * sc.y); wv.y = pk2(acc[db][4 * q + 2] * sc.z, acc[db][4 * q + 3] * sc.w);
                        if (!sample) *(u32x2*)(op + d) = wv; else *(u32x2*)(opf + foff(b * DS + t, g * 128 + d, 1024)) = wv; }
            }
        }
    }
    __syncthreads();
}

__device__ __forceinline__ void mem_unit(unsigned char* lds, const Params& p, int l, int unit) {
    const bf16_t* MQ = (const bf16_t*)(p.ws + WS_MQ); bf16_t* CAT = (bf16_t*)(p.ws + WS_CAT);
    size_t row0; int hd, nq, ldk; const bf16_t* k; const bf16_t* v;
    if (unit < 256) {
        const int b = unit >> 6, qb = unit & 15; hd = (unit >> 4) & 3; row0 = (size_t)b * SEQ + qb * 256; nq = 256; ldk = 1024;
        k = (const bf16_t*)(p.ws + WS_MKVP) + (size_t)l * 1024 * 1024 + (size_t)b * NMEM * 1024 + hd * 128; v = k + 512;
    } else {
        const int s = unit - 256, b = s >> 2; hd = s & 3; row0 = (size_t)MP + b * DS; nq = DS; ldk = 512;
        k = (const bf16_t*)(p.ws + WS_MKS) + ((size_t)l * DB * NMEM + (size_t)b * NMEM) * 512 + hd * 128;
        v = (const bf16_t*)(p.ws + WS_MVS) + ((size_t)l * DB * NMEM + (size_t)b * NMEM) * 512 + hd * 128;
    }
    if (unit < 256) attn_unit<128, false>(lds, MQ + row0 * 512 + hd * 128, 512, nq, k, v, ldk, NMEM, 0, nullptr, CAT + row0 * 1024 + 512 + hd * 128, 1024);
    else attn_unit<128, false>(lds, MQ + row0 * 512 + hd * 128, 512, nq, k, v, ldk, NMEM, 0, nullptr, CAT + (size_t)MP * 1024, 1024, nullptr, nullptr, 0, (int)(row0 - MP), 512 + hd * 128);
}
__device__ __forceinline__ void fox_unit(unsigned char* lds, const Params& p, int unit) {
    const bf16_t* MI = (const bf16_t*)(p.ws + WS_MI); bf16_t* CAT = (bf16_t*)(p.ws + WS_CAT);
    float* biasL = (float*)(lds + 86016); float* wsum = (float*)(lds + 86016 + 18432);
    size_t row0; int hd, nq, nk, n1, npad, qpos0, nf32 = 0; const float* s1; const float* s2; const bf16_t* k; const bf16_t* v; const float* kf = nullptr; const float* vf = nullptr;
    if (unit < 512) {
        const int qb = 15 - (unit >> 5), bh = unit & 31, b = bh >> 3; hd = bh & 7; const size_t rowb = (size_t)b * SEQ; nk = (qb + 1) * 256; n1 = nk; npad = nk; nq = 256; qpos0 = qb * 256;
        row0 = rowb + qb * 256; s1 = p.out + O_LFP + rowb * 8 + hd; s2 = s1;
        k = (const bf16_t*)(p.ws + WS_KB) + rowb * 512 + hd * 64; v = (const bf16_t*)(p.ws + WS_VB) + rowb * 512 + hd * 64;
    } else {
        const int s = unit - 512, b = s >> 3; hd = s & 7; row0 = (size_t)MP + b * DS; nk = PAST + DS; n1 = PAST; npad = LKS; nq = DS; qpos0 = PAST;
        s1 = p.in[5] + (size_t)b * PAST * 8 + hd; s2 = p.out + O_LFS + (size_t)b * DS * 8 + hd;
        k = (const bf16_t*)(p.ws + WS_KSB) + (size_t)b * NKS * 512 + hd * 64; v = (const bf16_t*)(p.ws + WS_VSB) + (size_t)b * NKS * 512 + hd * 64;
        kf = p.in[3] + (size_t)b * PAST * 512 + hd * 64; vf = p.in[4] + (size_t)b * PAST * 512 + hd * 64; nf32 = PAST / 64;
    }
    const bool smp = unit >= 512;
    if (!smp) attn_unit<64, true, false>(lds, MI + row0 * 512 + hd * 64, 512, nq, k, v, 512, nk, qpos0, biasL, CAT + row0 * 1024 + hd * 64, 1024, nullptr, nullptr, 0, -1, 0, s1, n1, s2, npad, wsum);
    else attn_unit<64, true, true>(lds, MI + row0 * 512 + hd * 64, 512, nq, k, v, 512, nk, qpos0, biasL, CAT + (size_t)MP * 1024, 1024, kf, vf, nf32, (int)(row0 - MP), hd * 64, s1, n1, s2, npad, wsum);
}

__device__ __forceinline__ void cvt_unit(unsigned char* lds, const Params& p, int unit) {
    const int tid = tidx(), lane = tid & 63, wave = __builtin_amdgcn_readfirstlane(tid >> 6);
    float* scr = (float*)(lds + wave * 16640);
    constexpr int I_SQ = 16 * 16, I_UP = 16 * 64, I_DN = 64 * 16;
    int r = unit * 8 + wave;
    const float* W; const float* gain = nullptr; bf16_t* WT; int K = 1024, N = 1024, ldw = 1024;
    if (r < I_SQ) { W = p.in[13] + 1048576; gain = p.in[9] + 1024; WT = (bf16_t*)(p.ws + WS_WINKV); }
    else if ((r -= I_SQ) < I_SQ) { W = p.in[18]; ldw = 1032; gain = p.in[17]; WT = (bf16_t*)(p.ws + WS_WINKV) + 1048576; }
    else if ((r -= I_SQ) < I_SQ) { W = p.in[14]; WT = (bf16_t*)(p.ws + WS_WOUT); }
    else if ((r -= I_SQ) < I_SQ) { W = p.in[14] + 1048576; WT = (bf16_t*)(p.ws + WS_WOUT) + 1048576; }
    else if ((r -= I_SQ) < I_UP) { W = p.in[22]; N = 4096; ldw = 4096; gain = p.in[11]; WT = (bf16_t*)(p.ws + WS_WUP); }
    else if ((r -= I_UP) < I_UP) { W = p.in[22] + 4194304; N = 4096; ldw = 4096; gain = p.in[11] + 1024; WT = (bf16_t*)(p.ws + WS_WUP) + 4194304; }
    else if ((r -= I_UP) < I_DN) { W = p.in[23]; K = 4096; WT = (bf16_t*)(p.ws + WS_WDN); }
    else { r -= I_DN; W = p.in[23] + 4194304; K = 4096; WT = (bf16_t*)(p.ws + WS_WDN) + 4194304; }
    transpose_item(W, K, N, ldw, gain, WT, scr, r, lane);
}

#define LAS __attribute__((address_space(3)))
#define XB_TMO      128
#define XB_XCNT(j)  (256  + 64 * (j))
#define XB_XSUB(j)  (1280 + 64 * (j))
#define XB_XGEN(j)  (2304 + 64 * (j))
#define XB_TOP      3328
#define XB_TOPGEN   3392
#define XCD_BAR_WORDS 3456
#define XB_SPIN_CAP (1u << 18)

__device__ __forceinline__ unsigned xb_ld(unsigned* p)              { return __hip_atomic_load(p, __ATOMIC_RELAXED, __HIP_MEMORY_SCOPE_AGENT); }
__device__ __forceinline__ unsigned xb_add(unsigned* p, unsigned v) { return __hip_atomic_fetch_add(p, v, __ATOMIC_RELAXED, __HIP_MEMORY_SCOPE_AGENT); }
__device__ __forceinline__ unsigned xb_xcc_id() { return (unsigned)__builtin_amdgcn_s_getreg((3 << 11) | 20) & 0xFu; }
#define XB_SPIN(cond, bar) do { unsigned _sp = 0; while (cond) { __builtin_amdgcn_s_sleep(1); \
    if ((++_sp & 255u) == 0u) { if (xb_ld(&(bar)[XB_TMO])) break; if (_sp > XB_SPIN_CAP) { atomicAdd(&(bar)[XB_TMO], 1u); break; } } } } while (0)

struct XcdBarrier {
    unsigned* bar; unsigned x;
    volatile LAS unsigned* st;
};

__device__ __forceinline__ XcdBarrier xcd_barrier_post(unsigned* bar, volatile LAS unsigned* st) {
    XcdBarrier b; b.bar = bar; b.x = xb_xcc_id(); b.st = st;
    if (tidx() == 0) (void)xb_add(&bar[XB_XCNT(b.x)], 1u);
    return b;
}
__device__ __forceinline__ void xcd_barrier_complete(unsigned* bar, unsigned x, unsigned& nloc, unsigned& nx) {
    const unsigned G = gridDim.x * gridDim.y * gridDim.z;
    unsigned sum, cnt, mine, sp = 0u;
    for (;;) {
        sum = 0u; cnt = 0u; mine = 0u;
#pragma unroll
        for (unsigned j = 0; j < 16; ++j) { const unsigned c = xb_ld(&bar[XB_XCNT(j)]); sum += c; cnt += (c > 0u) ? 1u : 0u; mine = (j == x) ? c : mine; }
        if (sum == G) break;
        __builtin_amdgcn_s_sleep(1);
        if ((++sp & 255u) == 0u) { if (xb_ld(&bar[XB_TMO])) break; if (sp > XB_SPIN_CAP) { atomicAdd(&bar[XB_TMO], 1u); break; } }
    }
    nloc = mine > 0u ? mine : 1u; nx = cnt > 0u ? cnt : 1u;
}

__device__ __forceinline__ void xcd_barrier(const XcdBarrier& b) {
    asm volatile("s_waitcnt vmcnt(0)" ::: "memory");
    __syncthreads();
    if (tidx() == 0) {
        unsigned* bar = b.bar;
        __builtin_amdgcn_s_waitcnt(0);
        unsigned nloc = b.st[0], nx = b.st[1];
        if (nloc == 0u) { xcd_barrier_complete(bar, b.x, nloc, nx); b.st[0] = nloc; b.st[1] = nx; }
        const unsigned old = xb_add(&bar[XB_XSUB(b.x)], 1u);
        const unsigned gen = old / nloc;
        if (old + 1u == (gen + 1u) * nloc) {
            __builtin_amdgcn_fence(__ATOMIC_RELEASE, "agent");
            asm volatile("s_waitcnt vmcnt(0)" ::: "memory");
            const unsigned og = xb_add(&bar[XB_TOP], 1u);
            const unsigned tg = og / nx;
            if (og + 1u == (tg + 1u) * nx) xb_add(&bar[XB_TOPGEN], 1u);
            else XB_SPIN(xb_ld(&bar[XB_TOPGEN]) == tg, bar);
            __builtin_amdgcn_fence(__ATOMIC_ACQUIRE, "agent");
            xb_add(&bar[XB_XGEN(b.x)], 1u);
            asm volatile("s_waitcnt vmcnt(0)" ::: "memory");
        } else {
            XB_SPIN(xb_ld(&bar[XB_XGEN(b.x)]) == gen, bar);
            __builtin_amdgcn_fence(__ATOMIC_ACQUIRE, "agent");
            asm volatile("s_waitcnt vmcnt(0)" ::: "memory");
        }
    }
    __syncthreads();
}

#ifndef ENMASK
#define ENMASK 63
#endif
#define EN(t) (((ENMASK) >> (t)) & 1)
#define IN(k) (lo <= (k) && (k) < hi)
#define SEAM(k) do { if (IN(k) && IN((k) + 1)) xcd_barrier(bar); } while (0)
template <int l>
__device__ __forceinline__ void layer_phases(const Params& p, unsigned char* lds, const XcdBarrier& bar, int lo, int hi) {
    const int tid = tidx(), lane = tid & 63, wave = __builtin_amdgcn_readfirstlane(tid >> 6);
    const int G = gridDim.x, bx = blockIdx.x;
    unsigned* ctl = (unsigned*)(p.ws + WS_CTL);
    float* slots = (float*)(p.ws + WS_SLOTS);
    int* qslot = (int*)(lds + MISC_OFF);
    float* ldsf = (float*)lds;
    PG8_LAS unsigned char* lds3 = (PG8_LAS unsigned char*)lds;
    bf16_t* XN = (bf16_t*)(p.ws + WS_XN);
    float* X = p.out + O_Y;
    float* ssq = (float*)(p.ws + WS_SSQ); float* ssq_s = ssq + (size_t)MP * 16;
    float* rsL = (float*)(lds + RING_BYTES); const PG8_LAS float* rsL3 = (const PG8_LAS float*)(lds3 + RING_BYTES);
    (void)wave; (void)ctl; (void)slots; (void)qslot;
        const int pb = 1 + 5 * l;
        if (EN(1) && IN(pb)) {
            bf16_t* MIb = (bf16_t*)(p.ws + WS_MI); bf16_t* MQb = (bf16_t*)(p.ws + WS_MQ);
            const float smi = l == 0 ? 1.f : CFOX, smq = CMEM;
            const int nsk_s = l == 0 ? 32 : 64, nsk = l == 0 ? 32 + 512 : 64 + 129;
#ifndef PROBE_SK
#define PROBE_SK 1
#endif
            for (int reps = 0; reps < PROBE_SK; ++reps)
            for (int u = bx; u < nsk; u += G) {
                f32x4 o[2];
                if (u < nsk_s) {
                    skinny_gemm(XN + (size_t)MP * DM, (const bf16_t*)(p.ws + (l == 0 ? WS_WIN0 : WS_WINKV)), 1024, 0, u * 32, ldsf, o);
                    const int w = tid >> 6, r32 = lane & 31, h = lane >> 5; const int row = 32 * (w >> 1) + r32;
                    const float rsr = l == 1 ? sample_rs(ssq_s, row) : 1.f;
#pragma unroll
                    for (int g = 0; g < 2; ++g) { const int col = u * 32 + 16 * (w & 1) + 8 * g + 4 * h; const int sec = col >> 9, cc = col & 511; const f32x4 v = o[g] * rsr;
                        if (sec < 2) { const float sc = sec == 0 ? smi : smq; u32x2 wv; wv.x = pk2(v.x * sc, v.y * sc); wv.y = pk2(v.z * sc, v.w * sc); *(u32x2*)((sec == 0 ? MIb : MQb) + (size_t)(MP + row) * 512 + cc) = wv; }
                        else { *(f32x4*)(p.out + (sec == 2 ? O_KS : O_VS) + (size_t)row * 512 + cc) = v; u32x2 wv; wv.x = pk2(v.x, v.y); wv.y = pk2(v.z, v.w);
                            *(u32x2*)((bf16_t*)(p.ws + (sec == 2 ? WS_KSB : WS_VSB)) + ((size_t)(row >> 4) * NKS + (row & 15)) * 512 + cc) = wv; } }
                } else if (l == 1) {
                    const int ug = u - 64;
                    if (ug < 128) skinny_gemm<false>(XN, (const bf16_t*)(p.ws + WS_WF), 1024, ug * 128, 0, ldsf, o);
                    else skinny_gemm<true>(XN + (size_t)MP * DM, (const bf16_t*)(p.ws + WS_WF), 1024, 0, 0, ldsf, o);
                    const int w = tid >> 6, r32 = lane & 31, h = lane >> 5; const int m = ug * 128 + 32 * (w >> 1) + r32;
                    float rsm;
                    if (m < MP) { const f32x4* q = (const f32x4*)(ssq + (size_t)m * 16); float t = 0.f;
#pragma unroll
                        for (int i = 0; i < 4; ++i) { const f32x4 v = q[i]; t += (v.x + v.y) + (v.z + v.w); }
                        rsm = 1.0f / sqrtf(t * (1.0f / 1024.0f) + 1e-6f); }
                    else rsm = sample_rs(ssq_s, m - MP);
                    if ((w & 1) == 0) { const f32x4 bfv = *(const f32x4*)(p.in[19] + 4 * h); f32x4 lf;
#pragma unroll
                        for (int e = 0; e < 4; ++e) { const float v = o[0][e] * rsm + bfv[e]; lf[e] = fminf(v, 0.f) - log1pf(expf(-fabsf(v))); }
                        if (m < MP) *(f32x4*)(p.out + O_LFP + (size_t)m * 8 + 4 * h) = lf; else *(f32x4*)(p.out + O_LFS + (size_t)(m - MP) * 8 + 4 * h) = lf; }
                } else {
                    const int v_ = u - 32, ly = v_ >> 8, rg = (v_ >> 5) & 7, cu = v_ & 31;
                    skinny_gemm((const bf16_t*)(p.ws + WS_MN), (const bf16_t*)(p.ws + WS_WMEM) + (size_t)ly * 1048576, 1024, rg * 128, cu * 32, ldsf, o);
                    const int w = tid >> 6, r32 = lane & 31, h = lane >> 5; const int row = rg * 128 + 32 * (w >> 1) + r32;
#pragma unroll
                    for (int g = 0; g < 2; ++g) { const int col = cu * 32 + 16 * (w & 1) + 8 * g + 4 * h; const f32x4 v = o[g];
                        *(f32x4*)(p.out + (col < 512 ? O_MK : O_MV) + (size_t)ly * 524288 + (size_t)row * 512 + (col & 511)) = v;
                        u32x2 wv; wv.x = pk2(v.x, v.y); wv.y = pk2(v.z, v.w); *(u32x2*)((bf16_t*)(p.ws + WS_MKVP) + (size_t)ly * 1048576 + (size_t)row * 1024 + col) = wv; }
                }
            }
            __syncthreads();
            pg8::Gemm g{XN, (const bf16_t*)(p.ws + (l == 0 ? WS_WIN0 : WS_WINKV)), MP, l == 0 ? 1024 : 2048, 1024};
            pg8::StaticOrder S; S.init(MP, g.N, G, bx);
            if (l == 1) { pg8::Unit u0; if (S.next(0, u0)) panel_rs(ssq, u0.pm, rsL); else __syncthreads(); }
            pg8::EpiProj E{MIb, MQb, (bf16_t*)(p.ws + WS_KB), (bf16_t*)(p.ws + WS_VB), p.out + O_KP, p.out + O_VP, smi, smq, l == 1 ? rsL3 : (const PG8_LAS float*)nullptr};
            pg8::gemm_phase<pg8::EpiProj, pg8::StaticOrder, true, true>(lds3, g, S, E);
#ifndef PROBE_PROJ
#define PROBE_PROJ 1
#endif
            if (PROBE_PROJ > 1 && l == 0) { __syncthreads(); pg8::gemm_phase<pg8::EpiProj, pg8::StaticOrder, true, true>(lds3, g, S, E); }
        }
        SEAM(pb);
        if (EN(2) && IN(pb + 1)) {
#ifndef PROBE_MIX
#define PROBE_MIX 1
#endif
            #ifndef PROBE_MIX_L
#define PROBE_MIX_L 1
#endif
            for (int rep = 0; rep < (l == PROBE_MIX_L ? PROBE_MIX : 1); ++rep) {
            unsigned* qc = ctl + CW_Q + 64 * (l + 2 * rep);
            const int nunits = l == 0 ? (640 + 256 + 544 + 32) : (576 + 288);
            for (;;) {
                __syncthreads();
                if (tid == 0) *qslot = (int)atomicAdd(qc, 1u);
                __syncthreads();
                const int u = *qslot;
                if (u >= nunits) break;
                if (l == 0) { const bool cv = u < 1280 && (u & 1) == 0; const int cu = u < 1280 ? (u >> 1) : u - 640;
                    if (cv) cvt_unit(lds, p, u >> 1); else if (cu >= 256 && cu < 800) pool_unit(lds, p, cu - 256); else mem_unit(lds, p, 0, cu < 256 ? cu : cu - 544); }
                else { if (u < 576) fox_unit(lds, p, u < 64 ? 512 + u : u - 64); else mem_unit(lds, p, 1, u - 576); }
            }
            }
            __syncthreads();
        }
        SEAM(pb + 1);
        if (EN(3) && IN(pb + 2)) {
            const float* bases = l == 0 ? p.in[1] : X + (size_t)MP * DM;
            const int bk = 2 * l;
            float* sl1 = slots + (size_t)bk * SLOT_BANK; unsigned* c1 = ctl + CW_CNT + bk * 80 * 64;
            const bf16_t* Wt = (const bf16_t*)(p.ws + WS_WOUT) + (size_t)l * 1048576;
            for (int u = bx; u < 32; u += G) {
                f32x4 o[2];
                skinny_gemm((const bf16_t*)(p.ws + WS_CAT) + (size_t)MP * DM, Wt, 1024, 0, u * 32, ldsf, o);
                skinny_norm(o, u, bases, X + (size_t)MP * DM, XN + (size_t)MP * DM, ssq_s, p.in[10] + l * 1024, sl1 + 65536, c1 + 64 * 64, ldsf);
            }
            __syncthreads();
            pg8::Gemm g{(const bf16_t*)(p.ws + WS_CAT), Wt, MP, 1024, 1024};
            pg8::StaticOrder S; S.init(MP, 1024, G, bx);
            if (l == 0) { pg8::EpiNorm<true, false> E{p.in[0], nullptr, XN, ssq, p.in[10] + l * 1024, sl1, c1}; pg8::gemm_phase<pg8::EpiNorm<true, false>, pg8::StaticOrder, false, true>(lds3, g, S, E); }
            else { pg8::EpiNorm<false, false> E{XN, nullptr, XN, ssq, p.in[10] + l * 1024, sl1, c1}; pg8::gemm_phase<pg8::EpiNorm<false, false>, pg8::StaticOrder, false, true>(lds3, g, S, E); }
        }
        SEAM(pb + 2);
        if (EN(4) && IN(pb + 3)) {
            const bf16_t* Wt = (const bf16_t*)(p.ws + WS_WUP) + (size_t)l * 4194304; bf16_t* HB = (bf16_t*)(p.ws + WS_HB);
            for (int reps = 0; reps < PROBE_SK; ++reps)
            for (int u = bx; u < 128; u += G) {
                f32x4 o[2];
                skinny_gemm(XN + (size_t)MP * DM, Wt, 1024, 0, u * 32, ldsf, o);
                const int w = tid >> 6, r32 = lane & 31, h = lane >> 5; const int row = 32 * (w >> 1) + r32; const float rsr = sample_rs(ssq_s, row);
#pragma unroll
                for (int g = 0; g < 2; ++g) { const int col = u * 32 + 16 * (w & 1) + 8 * g + 4 * h; f32x4 v = o[g];
#pragma unroll
                    for (int e = 0; e < 4; ++e) { const float a = (v[e] > 0.f ? v[e] : 0.f) * rsr; v[e] = a * a; }
                    u32x2 wv; wv.x = pk2(v.x, v.y); wv.y = pk2(v.z, v.w); *(u32x2*)(HB + (size_t)MP * FF + foff(row, col, FF)) = wv; }
            }
            __syncthreads();
            pg8::Gemm g{XN, Wt, MP, FF, 1024};
            pg8::StaticOrder S; S.init(MP, FF, G, bx);
            { pg8::Unit u0; if (S.next(0, u0)) panel_rs(ssq, u0.pm, rsL); else __syncthreads(); }
            pg8::EpiUp E{HB, FF, rsL3};
#ifndef PROBE_UP
#define PROBE_UP 1
#endif
            pg8::gemm_phase<pg8::EpiUp, pg8::StaticOrder, true, true>(lds3, g, S, E);
            if (PROBE_UP > 1 && l == 0) { __syncthreads(); pg8::gemm_phase<pg8::EpiUp, pg8::StaticOrder, true, true>(lds3, g, S, E); }
        }
        SEAM(pb + 3);
        if (EN(5) && IN(pb + 4)) {
            const int bk = 2 * l + 1;
            float* sl1 = slots + (size_t)bk * SLOT_BANK; unsigned* c1 = ctl + CW_CNT + bk * 80 * 64;
            const bf16_t* Wt = (const bf16_t*)(p.ws + WS_WDN) + (size_t)l * 4194304; const bf16_t* HB = (const bf16_t*)(p.ws + WS_HB);
            for (int u = bx; u < 32; u += G) {
                f32x4 o[2];
                skinny_gemm(HB + (size_t)MP * FF, Wt, FF, 0, u * 32, ldsf, o);
                skinny_norm(o, u, X + (size_t)MP * DM, X + (size_t)MP * DM, l == 0 ? XN + (size_t)MP * DM : nullptr, ssq_s, p.in[12] + l * 1024, sl1 + 65536, c1 + 64 * 64, ldsf);
            }
            __syncthreads();
            int Kd = FF; asm volatile("" : "+s"(Kd));
            pg8::Gemm g{HB, Wt, MP, 1024, Kd};
            pg8::StaticOrder S; S.init(MP, 1024, G, bx);
            if (l == 0) { pg8::EpiNorm<false, false> E{XN, nullptr, XN, ssq, p.in[12] + l * 1024, sl1, c1}; pg8::gemm_phase<pg8::EpiNorm<false, false>, pg8::StaticOrder, false, true>(lds3, g, S, E); }
            else { pg8::EpiNorm<false, true> E{XN, X, nullptr, nullptr, p.in[12] + l * 1024, sl1, c1}; pg8::gemm_phase<pg8::EpiNorm<false, true>, pg8::StaticOrder, false, true>(lds3, g, S, E); }
        }
        if (l == 0) SEAM(pb + 4);

}
__global__ void __launch_bounds__(NTHR, 2) yoco_fwd(Params p) {
    unsigned char* lds = lds_raw_;
    cg::grid_group grid = cg::this_grid();
    { const unsigned key = (unsigned)__builtin_amdgcn_s_getreg((5 << 11) | 4) & 63u; if ((threadIdx.x & 63) == 0) ((volatile int*)(lds_raw_ + TIDX_LDS_OFF))[key] = (int)(threadIdx.x >> 6); }
    __syncthreads();
    const int tid = tidx(), lane = tid & 63, wave = __builtin_amdgcn_readfirstlane(tid >> 6);
    const int G = gridDim.x, bx = blockIdx.x;
    unsigned* ctl = (unsigned*)(p.ws + WS_CTL);
    float* slots = (float*)(p.ws + WS_SLOTS);
    int* qslot = (int*)(lds + MISC_OFF);
    float* ldsf = (float*)lds;
    PG8_LAS unsigned char* lds3 = (PG8_LAS unsigned char*)lds;
    bf16_t* XN = (bf16_t*)(p.ws + WS_XN);
    float* X = p.out + O_Y;
    const int lo = p.ph_lo, hi = p.ph_hi;
    if (tid < 32) ((volatile unsigned*)(lds + MISC_OFF))[tid] = 0u;
    __syncthreads();
    XcdBarrier bar = xcd_barrier_post(ctl + CW_BAR, (volatile LAS unsigned*)(lds + MISC_OFF) + 8);

#ifndef PROBE_P0
#define PROBE_P0 1
#endif
    if (EN(0) && IN(0)) for (int rep0 = 0; rep0 < PROBE_P0; ++rep0) {
        float* scr = (float*)(lds + wave * 16640);
        const int gw = bx * 8 + wave, NGW = G * 8;
        constexpr int I_SQ = 16 * 16, I_PL = 2 * 2;
        constexpr int NITEMS = 3 * I_SQ + 4 * I_PL;
        for (int it = gw; it < NITEMS; it += NGW) {
            int r = it;
            if (r < I_SQ) { transpose_item(p.in[13], 1024, 1024, 1024, p.in[9], (bf16_t*)(p.ws + WS_WIN0), scr, r, lane); continue; } r -= I_SQ;
            if (r < I_SQ) { transpose_item(p.in[21], 1024, 1024, 1024, p.in[20], (bf16_t*)(p.ws + WS_WMEM), scr, r, lane); continue; } r -= I_SQ;
            if (r < I_SQ) { transpose_item(p.in[21] + 1048576, 1024, 1024, 1024, p.in[20] + 1024, (bf16_t*)(p.ws + WS_WMEM) + 1048576, scr, r, lane); continue; } r -= I_SQ;
            { const int gq = r / I_PL; transpose_item(p.in[15] + gq * 16384, 128, 128, 128, nullptr, (bf16_t*)(p.ws + WS_WPOOL) + gq * 16384, scr, r % I_PL, lane); }
        }
        for (int m = gw; m < MT + 1024; m += NGW) {
            if (m < MP) norm_row_to_bf16(p.in[0] + (size_t)m * DM, XN + (size_t)m * DM, lane);
            else if (m < MT) norm_row_to_bf16(p.in[1] + (size_t)(m - MP) * DM, XN + (size_t)MP * DM, lane, m - MP);
            else norm_row_to_bf16(p.in[8] + (size_t)(m - MT) * DM, (bf16_t*)(p.ws + WS_MN), lane, m - MT);
        }
        const size_t gtid = (size_t)bx * NTHR + tid, gn = (size_t)G * NTHR;
        cvt_rows(p.in[6], (bf16_t*)(p.ws + WS_MKS), (size_t)2 * DB * NMEM * 512 / 8, 64, 1, 1, gtid, gn);
        cvt_rows(p.in[7], (bf16_t*)(p.ws + WS_MVS), (size_t)2 * DB * NMEM * 512 / 8, 64, 1, 1, gtid, gn);
        for (size_t i = gtid; i < 32 * 1024; i += gn) { const int rr = (int)(i >> 10), k = (int)(i & 1023); const float v = rr < 8 ? p.in[17][k] * p.in[18][(size_t)k * 1032 + 1024 + rr] : 0.f; ((bf16_t*)(p.ws + WS_WF))[i] = f2bf(v); }
        __syncthreads();
    }
    SEAM(0);

    layer_phases<0>(p, lds, bar, lo, hi);
    layer_phases<1>(p, lds, bar, lo, hi);
    if (hi > 1000) grid.sync();
#undef IN
#undef SEAM
}

#ifndef MK_N_LAUNCHES
#define MK_N_LAUNCHES 1
#endif
extern "C" void kernel_launch(void* const* d_in, const int* in_sizes, int n_in, void* d_out, int out_size, void* d_ws, size_t ws_size, hipStream_t stream) {
    static int grid = 0;
    if (grid == 0) {
        if (n_in != 24 || ws_size < WS_END) { fprintf(stderr, "kernel_launch: unexpected problem (n_in %d, ws %zu)\n", n_in, ws_size); grid = -1; return; }
        int dev = 0, cus = 0, per_cu = 0;
        if (hipGetDevice(&dev) != hipSuccess || hipDeviceGetAttribute(&cus, hipDeviceAttributeMultiprocessorCount, dev) != hipSuccess) { grid = -1; return; }
        if (hipFuncSetAttribute((const void*)yoco_fwd, hipFuncAttributeMaxDynamicSharedMemorySize, LDS_BYTES) != hipSuccess) { fprintf(stderr, "kernel_launch: hipFuncSetAttribute failed\n"); grid = -1; return; }
        if (hipOccupancyMaxActiveBlocksPerMultiprocessor(&per_cu, (const void*)yoco_fwd, NTHR, LDS_BYTES) != hipSuccess || per_cu < 1) { fprintf(stderr, "kernel_launch: occupancy query says %d\n", per_cu); per_cu = 1; }
        (void)hipGetLastError();
        grid = cus;
        if (grid != 256) fprintf(stderr, "kernel_launch: %d CUs; this kernel is built for 256\n", grid);
    }
    if (grid < 0) return;
    (void)hipMemsetAsync((char*)d_ws + WS_CTL, 0, CTL_BYTES, stream);
    Params a{};
    for (int i = 0; i < 24; ++i) a.in[i] = (const float*)d_in[i];
    a.out = (float*)d_out; a.ws = (unsigned char*)d_ws;
    constexpr int NPH = 11;
    if (MK_N_LAUNCHES == 1) {
        a.ph_lo = 0; a.ph_hi = NPH;
        void* args[] = {&a};
        hipError_t e = hipLaunchCooperativeKernel((const void*)yoco_fwd, dim3(grid), dim3(NTHR), args, LDS_BYTES, stream);
        if (e != hipSuccess) fprintf(stderr, "cooperative launch failed: %s (grid %d)\n", hipGetErrorString(e), grid);
    } else {
        for (int ph = 0; ph < NPH; ++ph) {
            a.ph_lo = ph; a.ph_hi = ph + 1;
            void* args[] = {&a};
            hipError_t e = hipLaunchCooperativeKernel((const void*)yoco_fwd, dim3(grid), dim3(NTHR), args, LDS_BYTES, stream);
            if (e != hipSuccess) { fprintf(stderr, "cooperative launch %d failed: %s (grid %d)\n", ph, hipGetErrorString(e), grid); break; }
        }
    }
}
```
